# Optimizing an MI355X kernel written in HIP

```python
import jax
import jax.numpy as jnp
from jax import lax
import numpy as np

D_MODEL = 2048
BATCH = 2
SEQ = 8192
DEPTH = 4

GRID_W = 64
CTX_LEN = 256
HEAD_DIM = 64
D_RWKV = D_MODEL // 2
N_RWKV_HEADS = D_RWKV // HEAD_DIM
D_CONV = D_MODEL // 4
D_FOURIER = D_MODEL // 4
N_FOURIER_GROUPS = D_FOURIER // HEAD_DIM
D_MIX = D_RWKV + D_CONV + D_FOURIER
DECAY_LORA = 96
ICLR_LORA = 96
GATE_LORA = 256
D_FF = ((8 * D_MODEL + 3 * 256 - 1) // (3 * 256)) * 256
N_MOD = 6
RMS_EPS = 1e-6
GN_EPS = 64e-5
KK_EPS = 1e-12

R0 = 0
K0 = R0 + D_RWKV
V0 = K0 + D_RWKV
WD0 = V0 + D_RWKV
AD0 = WD0 + DECAY_LORA
GD0 = AD0 + ICLR_LORA
RW_COLS = GD0 + GATE_LORA
CG0 = RW_COLS
CX0 = CG0 + D_CONV
CB0 = CX0 + D_CONV
FT0 = CB0 + D_CONV
D_IN = FT0 + D_FOURIER

kernel_name = "hybrid_rwkv7_shortconv_fnet_dit"


def rms_norm(x, g):
    xf = x.astype(jnp.float32)
    y = xf * lax.rsqrt(jnp.mean(xf * xf, axis=-1, keepdims=True) + RMS_EPS)
    return (y * g.astype(jnp.float32)).astype(x.dtype)


def adaln(cvec, w, b):
    m = jax.nn.silu(cvec) @ w + b
    return jnp.split(m[:, None, :], N_MOD, axis=-1)


def modulate(h, shift, scale):
    return h * (1.0 + scale) + shift


def conv3(u, w):
    pad = [(0, 0)] * (u.ndim - 2) + [(1, 1), (0, 0)]
    up = jnp.pad(u, pad)
    return up[..., :-2, :] * w[0] + up[..., 1:-1, :] * w[1] + up[..., 2:, :] * w[2]


def grid_conv3(u, w):
    b, l, ch = u.shape
    rows = l // GRID_W
    return conv3(u.reshape(b, rows, GRID_W, ch), w).reshape(b, l, ch)


def rwkv_streams(rw, dec_w0, dec_up, iclr_a0, iclr_up, k_k, k_a):
    rw = rw.astype(jnp.float32)
    b, l = rw.shape[:2]

    def heads(t):
        return t.reshape(b, l, N_RWKV_HEADS, HEAD_DIM)

    r = rw[..., R0:K0]
    k = rw[..., K0:V0]
    v = rw[..., V0:WD0]
    wd = jnp.tanh(rw[..., WD0:AD0])
    ad = rw[..., AD0:GD0]
    gd = rw[..., GD0:RW_COLS]
    kk = heads(k * k_k)
    kk = kk / jnp.maximum(jnp.sqrt(jnp.sum(kk * kk, axis=-1, keepdims=True)), KK_EPS)
    per_dir = []
    for d in range(2):
        w_log = -jax.nn.softplus(-(dec_w0[d] + wd @ dec_up[d])) - 0.5
        a = jax.nn.sigmoid(iclr_a0[d] + ad @ iclr_up[d])
        kd = k * (1.0 + (a - 1.0) * k_a)
        per_dir.append((heads(jnp.exp(-jnp.exp(w_log))), heads(kd), heads(a)))
    return heads(r), heads(v), kk, per_dir, gd


def wkv_scan(r, w, k, v, kk, a, s0, reverse):
    def step(s, inp):
        r_t, w_t, k_t, v_t, kk_t, a_t = inp
        sa = jnp.einsum('bhij,bhj->bhi', s, -kk_t)
        s = (s * w_t[:, :, None, :] + sa[..., None] * (kk_t * a_t)[:, :, None, :]
             + v_t[..., None] * k_t[:, :, None, :])
        return s, jnp.einsum('bhij,bhj->bhi', s, r_t)

    xs = tuple(jnp.moveaxis(t, 1, 0) for t in (r, w, k, v, kk, a))
    s_fin, ys = lax.scan(step, s0, xs, reverse=reverse)
    return jnp.moveaxis(ys, 0, 1), s_fin


def rwkv_mix(streams, s0, ln_w, ln_b, r_k, g_up):
    r, v, kk, per_dir, gd = streams
    (wf, kf, af), (wb, kb, ab) = per_dir
    yf, sf = wkv_scan(r, wf, kf, v, kk, af, s0[0], False)
    yb, sb = wkv_scan(r, wb, kb, v, kk, ab, s0[1], True)
    y = yf + yb
    mu = jnp.mean(y, axis=-1, keepdims=True)
    var = jnp.mean(jnp.square(y - mu), axis=-1, keepdims=True)
    y = ((y - mu) * lax.rsqrt(var + GN_EPS) * ln_w.reshape(N_RWKV_HEADS, HEAD_DIM)
         + ln_b.reshape(N_RWKV_HEADS, HEAD_DIM))
    y = y + jnp.sum(r * (kf + kb) * r_k, axis=-1, keepdims=True) * v
    b, l = y.shape[:2]
    g = jax.nn.sigmoid(gd) @ g_up
    return y.reshape(b, l, D_RWKV) * g, (sf, sb)


def short_conv_mix(p, conv_w, conv_fn):
    return p[..., CB0:FT0] * conv_fn(p[..., CG0:CX0] * p[..., CX0:CB0], conv_w)


def fourier_mix(p):
    u = p[..., FT0:D_IN].astype(jnp.float32)
    b, l = u.shape[:2]
    u = u.reshape(b, l, N_FOURIER_GROUPS, HEAD_DIM)
    y = jnp.fft.fftn(u, axes=(1, 3), norm='ortho').real
    return y.reshape(b, l, D_FOURIER).astype(p.dtype)


def ffn(h, wg, wu, wd):
    return (jax.nn.silu(h @ wg) * (h @ wu)) @ wd


def setup_inputs(seed: int = 0) -> dict:
    key = jax.random.key(seed)
    ks = jax.random.split(key, 32)
    f32 = jnp.float32

    def nrm(k, shape, s):
        return jax.random.normal(k, shape, f32) * s

    L = DEPTH
    left = jax.random.uniform(ks[8], (L, 1, RW_COLS), f32, 0.0, 0.4)
    right = jax.random.uniform(ks[9], (L, 1, RW_COLS), f32, 0.0, 0.4)
    rw_shift = jnp.concatenate([left, 1.0 - 0.5 * (left + right), right], axis=1)
    return {
        'x': nrm(ks[0], (BATCH, SEQ, D_MODEL), 1.0),
        'c': nrm(ks[1], (BATCH, D_MODEL), 1.0),
        'ctx': nrm(ks[2], (BATCH, CTX_LEN, D_MODEL), 1.0),
        'c_ctx': nrm(ks[3], (D_MODEL,), 1.0),
        'w_mod': nrm(ks[4], (L, D_MODEL, N_MOD * D_MODEL), 0.5 * D_MODEL ** -0.5),
        'b_mod': nrm(ks[5], (L, N_MOD * D_MODEL), 0.02),
        'norm_mix': 1.0 + nrm(ks[6], (L, D_MODEL), 0.05),
        'w_in': nrm(ks[7], (L, D_MODEL, D_IN), D_MODEL ** -0.5),
        'rw_shift': rw_shift,
        'dec_w0': jax.random.uniform(ks[10], (L, 2, D_RWKV), f32, -6.0, 1.0),
        'dec_up': nrm(ks[11], (L, 2, DECAY_LORA, D_RWKV), 0.5 * DECAY_LORA ** -0.5),
        'iclr_a0': nrm(ks[12], (L, 2, D_RWKV), 0.1),
        'iclr_up': nrm(ks[13], (L, 2, ICLR_LORA, D_RWKV), 0.5 * ICLR_LORA ** -0.5),
        'k_k': 0.85 + nrm(ks[14], (L, D_RWKV), 0.05),
        'k_a': 1.0 + nrm(ks[15], (L, D_RWKV), 0.05),
        'r_k': nrm(ks[16], (L, N_RWKV_HEADS, HEAD_DIM), 0.1),
        'ln_w': 1.0 + nrm(ks[17], (L, D_RWKV), 0.05),
        'ln_b': nrm(ks[18], (L, D_RWKV), 0.02),
        'g_up': nrm(ks[19], (L, GATE_LORA, D_RWKV), GATE_LORA ** -0.5),
        'conv_w': nrm(ks[20], (L, 3, D_CONV), 0.5),
        'w_out': nrm(ks[21], (L, D_MIX, D_MODEL), D_MIX ** -0.5),
        'norm_ffn': 1.0 + nrm(ks[22], (L, D_MODEL), 0.05),
        'w_gate': nrm(ks[23], (L, D_MODEL, D_FF), D_MODEL ** -0.5),
        'w_up': nrm(ks[24], (L, D_MODEL, D_FF), D_MODEL ** -0.5),
        'w_down': nrm(ks[25], (L, D_FF, D_MODEL), D_FF ** -0.5),
        'norm_final': 1.0 + nrm(ks[26], (D_MODEL,), 0.05),
    }


def reference(x, c, ctx, c_ctx, w_mod, b_mod, norm_mix, w_in, rw_shift, dec_w0, dec_up,
              iclr_a0, iclr_up, k_k, k_a, r_k, ln_w, ln_b, g_up, conv_w, w_out,
              norm_ffn, w_gate, w_up, w_down, norm_final):
    xc = ctx
    s_zero = jnp.zeros((ctx.shape[0], N_RWKV_HEADS, HEAD_DIM, HEAD_DIM), jnp.float32)
    for i in range(DEPTH):
        sh1, sc1, ga1, sh2, sc2, ga2 = adaln(c, w_mod[i], b_mod[i])
        csh1, csc1, cga1, csh2, csc2, cga2 = adaln(c_ctx[None, :], w_mod[i], b_mod[i])
        px = modulate(rms_norm(x, norm_mix[i]), sh1, sc1) @ w_in[i]
        pc = modulate(rms_norm(xc, norm_mix[i]), csh1, csc1) @ w_in[i]
        rw_args = (dec_w0[i], dec_up[i], iclr_a0[i], iclr_up[i], k_k[i], k_a[i])
        out_args = (ln_w[i], ln_b[i], r_k[i], g_up[i])
        yc_rw, s_ctx = rwkv_mix(rwkv_streams(conv3(pc[..., :RW_COLS], rw_shift[i]), *rw_args),
                                (s_zero, s_zero), *out_args)
        yx_rw, _ = rwkv_mix(rwkv_streams(conv3(px[..., :RW_COLS], rw_shift[i]), *rw_args),
                            s_ctx, *out_args)
        yx = jnp.concatenate([yx_rw.astype(px.dtype),
                              short_conv_mix(px, conv_w[i], grid_conv3),
                              fourier_mix(px)], axis=-1) @ w_out[i]
        x = x + ga1 * yx
        x = x + ga2 * ffn(modulate(rms_norm(x, norm_ffn[i]), sh2, sc2),
                          w_gate[i], w_up[i], w_down[i])
        if i < DEPTH - 1:
            yc = jnp.concatenate([yc_rw.astype(pc.dtype),
                                  short_conv_mix(pc, conv_w[i], conv3),
                                  fourier_mix(pc)], axis=-1) @ w_out[i]
            xc = xc + cga1 * yc
            xc = xc + cga2 * ffn(modulate(rms_norm(xc, norm_ffn[i]), csh2, csc2),
                                 w_gate[i], w_up[i], w_down[i])
    return rms_norm(x, norm_final)
```

```cpp
#include <hip/hip_runtime.h>
#include <cstdio>
#include <cstdint>

#ifndef MK_ONE_LAUNCH
#define MK_ONE_LAUNCH 1
#endif

namespace pg8 {
#define PG8_LAS __attribute__((address_space(3)))
typedef unsigned short bf16_t;
typedef short bf16x8 __attribute__((ext_vector_type(8)));
typedef float f32x4 __attribute__((ext_vector_type(4)));
typedef unsigned u32x4 __attribute__((ext_vector_type(4)));
typedef unsigned u32x2 __attribute__((ext_vector_type(2)));
constexpr int BM = 256, BK = 64, HALF = 128, HTB = HALF * BK * 2, STAGE_BYTES = 8 * HTB, NXCD = 8, WGM = 8;

__host__ __device__ __forceinline__ int lds_byte(int r, int c) { const int st = (r >> 4) * 2 + (c >> 5), rr = r & 15, cc = c & 31, ob = rr * 64 + cc * 2; return st * 1024 + (ob ^ (((ob >> 9) & 1) << 5)); }
__host__ __device__ __forceinline__ void stage_rc(int b, int& R, int& C) { const int st = b / 1024, sb = b % 1024, swz = sb ^ (((sb >> 9) & 1) << 5); R = (st >> 1) * 16 + swz / 64; C = (st & 1) * 32 + (swz % 64) / 2; }
__host__ __device__ __forceinline__ int perm32(int rho) { const int n = rho >> 4, i = rho & 15; return 8 * (i >> 2) + 4 * n + (i & 3); }

struct Unit { int pm, pn; };
struct Gemm { const bf16_t* A; const bf16_t* Bt; int M, N, K, lda, ldb; };

struct StaticOrder {
    static constexpr bool SPLIT = false;
    int nM, nN, nwg, G, c;
    __host__ __device__ void init(int M, int N, int G_, int c_) { nM = M / BM; nN = N / BM; nwg = nM * nN; G = G_; c = c_; }
    __host__ __device__ __forceinline__ bool next(int i, Unit& u) const {
        const long L = (long)i * G + c; if (L >= nwg) return false;
        int wgid = (int)L; { const int q = nwg / NXCD, r = nwg % NXCD, xcd = wgid % NXCD, off = wgid / NXCD; wgid = (xcd < r ? xcd * (q + 1) : r * (q + 1) + (xcd - r) * q) + off; }
        const int nig = WGM * nN, gid = wgid / nig, fm = gid * WGM, gsz = (nM - fm) < WGM ? (nM - fm) : WGM;
        u.pm = fm + ((wgid % nig) % gsz); u.pn = (wgid % nig) / gsz; return true;
    }
    __device__ __forceinline__ void a_ready(const Unit&) const {}
    __device__ __forceinline__ void done(const Unit&) const {}
};

struct SplitOrder {
    static constexpr bool SPLIT = true;
    StaticOrder so; int nlat, nsub, KS, nkt, nMl, nNn, G, c, ntfull;
    __host__ __device__ void init(int Ml, int nctx, int N, int Ktiles, int KS_, int G_, int c_) { so.init(Ml, N, G_, c_); nlat = so.nwg; KS = KS_; nkt = Ktiles / KS_; nMl = Ml / BM; nNn = N / BM; nsub = nctx * nNn * KS_; G = G_; c = c_; ntfull = Ktiles; }
    __host__ __device__ __forceinline__ bool next(int i, Unit& u) const {
        const long L = (long)i * G + c;
        if (L < nlat) { so.next(i, u); return true; }
        const int sub = (int)(L - nlat); if (sub >= nsub) return false;
        const int tile = sub / KS, ks = sub - tile * KS; u.pm = nMl + tile / nNn; u.pn = (tile % nNn) | ((ks + 1) << 8); return true;
    }
    __device__ __forceinline__ void a_ready(const Unit&) const {}
    __device__ __forceinline__ void done(const Unit&) const {}
};

typedef __bf16 bf2_t __attribute__((ext_vector_type(2)));
typedef float f2_t __attribute__((ext_vector_type(2)));
__device__ __forceinline__ unsigned cvt_pk_bf16(float lo, float hi) { const f2_t v = {lo, hi}; return __builtin_bit_cast(unsigned, __builtin_convertvector(v, bf2_t)); }
typedef _Float16 h2_t __attribute__((ext_vector_type(2)));
__device__ __forceinline__ unsigned pk_h2(float a, float b) { unsigned ha, hb; asm volatile("v_cvt_f16_f32 %0, %1" : "=v"(ha) : "v"(a)); asm volatile("v_cvt_f16_f32 %0, %1" : "=v"(hb) : "v"(b)); return (ha & 0xffffu) | (hb << 16); }
__device__ __forceinline__ void unpack_h2(unsigned w, float& lo, float& hi) { const unsigned wh = w >> 16; asm volatile("v_cvt_f32_f16 %0, %1" : "=v"(lo) : "v"(w)); asm volatile("v_cvt_f32_f16 %0, %1" : "=v"(hi) : "v"(wh)); }
__device__ __forceinline__ void unpack_h8(const u32x4 w, float (&f)[8]) { unpack_h2(w.x, f[0], f[1]); unpack_h2(w.y, f[2], f[3]); unpack_h2(w.z, f[4], f[5]); unpack_h2(w.w, f[6], f[7]); }
__device__ __forceinline__ u32x4 pack_h8(const float (&f)[8]) { u32x4 w; w.x = pk_h2(f[0], f[1]); w.y = pk_h2(f[2], f[3]); w.z = pk_h2(f[4], f[5]); w.w = pk_h2(f[6], f[7]); return w; }
__device__ __forceinline__ float sigmoidf_(float x) { return __builtin_amdgcn_rcpf(1.0f + __expf(-x)); }

struct EpiStoreBf16 {
    static constexpr bool PERM = true, AFTER_DRAIN = false;
    bf16_t* O; int ldc; int row_off, col_off; float scale;
    __device__ __forceinline__ void operator()(const f32x4 (&acc)[2][2][4][2], const Unit& u, int wr, int wc, int fr, int fq) const {
        asm volatile("" : "+v"(fr), "+v"(fq));
        const int row0 = row_off + u.pm * BM + wr * 64 + fr, col0 = col_off + u.pn * BM + wc * 32 + 8 * fq;
#pragma unroll
        for (int ai = 0; ai < 2; ++ai)
#pragma unroll
            for (int m = 0; m < 4; ++m) { bf16_t* rowp = O + (size_t)(row0 + ai * HALF + m * 16) * ldc + col0;
#pragma unroll
                for (int bj = 0; bj < 2; ++bj) { const f32x4 v0 = acc[ai][bj][m][0] * scale, v1 = acc[ai][bj][m][1] * scale;
                    u32x4 w; w.x = cvt_pk_bf16(v0[0], v0[1]); w.y = cvt_pk_bf16(v0[2], v0[3]); w.z = cvt_pk_bf16(v1[0], v1[1]); w.w = cvt_pk_bf16(v1[2], v1[3]);
                    *(u32x4*)(rowp + bj * HALF) = w; } }
    }
};
struct EpiSwiGLU {
    static constexpr bool PERM = true, AFTER_DRAIN = false;
    bf16_t* Hb; int ldc;
    __device__ __forceinline__ void operator()(const f32x4 (&acc)[2][2][4][2], const Unit& u, int wr, int wc, int fr, int fq) const {
        asm volatile("" : "+v"(fr), "+v"(fq));
        const int row0 = u.pm * BM + wr * 64 + fr, col0 = u.pn * HALF + wc * 32 + 8 * fq;
#pragma unroll
        for (int ai = 0; ai < 2; ++ai)
#pragma unroll
            for (int m = 0; m < 4; ++m) { bf16_t* rowp = Hb + (size_t)(row0 + ai * HALF + m * 16) * ldc + col0;
                f32x4 h0, h1;
#pragma unroll
                for (int j = 0; j < 4; ++j) { const float g0 = acc[ai][0][m][0][j], g1 = acc[ai][0][m][1][j];
                    h0[j] = g0 * sigmoidf_(g0) * acc[ai][1][m][0][j]; h1[j] = g1 * sigmoidf_(g1) * acc[ai][1][m][1][j]; }
                u32x4 w; w.x = cvt_pk_bf16(h0[0], h0[1]); w.y = cvt_pk_bf16(h0[2], h0[3]); w.z = cvt_pk_bf16(h1[0], h1[1]); w.w = cvt_pk_bf16(h1[2], h1[3]);
                *(u32x4*)rowp = w; }
    }
};
struct EpiResGate {
    static constexpr bool PERM = true, AFTER_DRAIN = false;
    unsigned short* X; const float* gate; float* part; const float* Xin32;
    __device__ __forceinline__ void operator()(const f32x4 (&acc)[2][2][4][2], const Unit& u, int wr, int wc, int fr, int fq) const {
        asm volatile("" : "+v"(fr), "+v"(fq));
        if (u.pn >> 8) {
            const int row0 = (u.pm - 64) * BM + wr * 64 + fr, col0 = (u.pn & 255) * BM + wc * 32 + 8 * fq;
            float* pb_ = part + (size_t)((u.pn >> 8) - 1) * 512 * 2048;
#pragma unroll
            for (int ai = 0; ai < 2; ++ai)
#pragma unroll
                for (int m = 0; m < 4; ++m) { float* rowp = pb_ + (size_t)(row0 + ai * HALF + m * 16) * 2048 + col0;
#pragma unroll
                    for (int bj = 0; bj < 2; ++bj) { *(f32x4*)(rowp + bj * HALF) = acc[ai][bj][m][0]; *(f32x4*)(rowp + bj * HALF + 4) = acc[ai][bj][m][1]; } }
            return;
        }
        const int j = u.pm < 32 ? 0 : (u.pm < 64 ? 1 : 2);
        const int row0 = u.pm * BM + wr * 64 + fr, col0 = u.pn * BM + wc * 32 + 8 * fq;
        const float* gv = gate + (size_t)j * 12288 + col0;
        f32x4 gt[2][2];
#pragma unroll
        for (int bj = 0; bj < 2; ++bj)
#pragma unroll
            for (int n = 0; n < 2; ++n) gt[bj][n] = *(const f32x4*)(gv + bj * HALF + 4 * n);
#pragma unroll
        for (int ai = 0; ai < 2; ++ai)
#pragma unroll
            for (int m = 0; m < 4; ++m) { const size_t ro = (size_t)(row0 + ai * HALF + m * 16) * 2048 + col0;
#pragma unroll
                for (int bj = 0; bj < 2; ++bj) { float xv[8];
                    if (Xin32) { const f32x4 a0 = *(const f32x4*)(Xin32 + ro + bj * HALF), a1 = *(const f32x4*)(Xin32 + ro + bj * HALF + 4);
                        xv[0] = a0[0]; xv[1] = a0[1]; xv[2] = a0[2]; xv[3] = a0[3]; xv[4] = a1[0]; xv[5] = a1[1]; xv[6] = a1[2]; xv[7] = a1[3]; }
                    else unpack_h8(*(const u32x4*)(X + ro + bj * HALF), xv);
#pragma unroll
                    for (int e = 0; e < 8; ++e) xv[e] += gt[bj][e >> 2][e & 3] * acc[ai][bj][m][e >> 2][e & 3];
                    *(u32x4*)(X + ro + bj * HALF) = pack_h8(xv); }
                asm volatile("" ::: "memory"); }
    }
};
struct EpiLora1 {
    static constexpr bool PERM = false, AFTER_DRAIN = false;
    unsigned short* LW; bf16_t* AA; const float* w0; const float* a0; size_t dstride;
    __device__ __forceinline__ void operator()(const f32x4 (&acc)[2][2][4][2], const Unit& u, int wr, int wc, int fr, int fq) const {
        asm volatile("" : "+v"(fr), "+v"(fq));
        const int blk = u.pn >> 2, d = blk & 1;
        const int row0 = u.pm * BM + wr * 64 + fr, col0 = (u.pn & 3) * BM + wc * 32 + 4 * fq;
        const float* bvp = (blk < 2 ? w0 : a0) + d * 1024 + col0;
        f32x4 bv[2][2];
#pragma unroll
        for (int bj = 0; bj < 2; ++bj)
#pragma unroll
            for (int n = 0; n < 2; ++n) bv[bj][n] = *(const f32x4*)(bvp + bj * HALF + n * 16);
        if (blk < 2) {
            unsigned short* base = LW + (size_t)d * dstride;
#pragma unroll
            for (int ai = 0; ai < 2; ++ai)
#pragma unroll
                for (int m = 0; m < 4; ++m) { unsigned short* rowp = base + (size_t)(row0 + ai * HALF + m * 16) * 1024 + col0;
#pragma unroll
                    for (int bj = 0; bj < 2; ++bj)
#pragma unroll
                        for (int n = 0; n < 2; ++n) { f32x4 o;
#pragma unroll
                            for (int j = 0; j < 4; ++j) { const float x = bv[bj][n][j] + acc[ai][bj][m][n][j];
                                o[j] = -0.6065306597126334f * sigmoidf_(x); }
                            u32x2 w; w.x = pk_h2(o[0], o[1]); w.y = pk_h2(o[2], o[3]); *(u32x2*)(rowp + bj * HALF + n * 16) = w; } }
        } else {
            bf16_t* base = AA + (size_t)d * dstride;
#pragma unroll
            for (int ai = 0; ai < 2; ++ai)
#pragma unroll
                for (int m = 0; m < 4; ++m) { bf16_t* rowp = base + (size_t)(row0 + ai * HALF + m * 16) * 1024 + col0;
#pragma unroll
                    for (int bj = 0; bj < 2; ++bj)
#pragma unroll
                        for (int n = 0; n < 2; ++n) { f32x4 o;
#pragma unroll
                            for (int j = 0; j < 4; ++j) o[j] = bv[bj][n][j] + acc[ai][bj][m][n][j];
                            u32x2 w; w.x = cvt_pk_bf16(o[0], o[1]); w.y = cvt_pk_bf16(o[2], o[3]);
                            *(u32x2*)(rowp + bj * HALF + n * 16) = w; } }
        }
    }
};

struct EpiFFT1 {
    static constexpr bool PERM = true, AFTER_DRAIN = false;
    bf16_t* D2;
    __device__ __forceinline__ void operator()(const f32x4 (&acc)[2][2][4][2], const Unit& u, int wr, int wc, int fr, int fq) const {
        asm volatile("" : "+v"(fr), "+v"(fq));
        const int l1 = 32 * (wc & 1) + 8 * fq;
#pragma unroll
        for (int mi = 0; mi < 4; ++mi) { const int l2p = wr * 64 + mi * 16 + fr;
#pragma unroll
            for (int bj = 0; bj < 2; ++bj) { const int nrow = 4 * u.pn + 2 * bj + (wc >> 1), b = nrow >> 9, ng = nrow & 511;
                float orr[8], oi[8];
#pragma unroll
                for (int e = 0; e < 8; ++e) { const float br = acc[0][bj][mi][e >> 2][e & 3], bi = acc[1][bj][mi][e >> 2][e & 3];
                    const float a = (float)((l1 + e) * l2p) * (1.0f / 8192.0f), ct = __builtin_amdgcn_cosf(a), st = __builtin_amdgcn_sinf(a);
                    orr[e] = br * ct + bi * st; oi[e] = bi * ct - br * st; }
                bf16_t* dst = D2 + (((size_t)(b * 128 + l2p) * 512 + ng) * 2) * 64 + l1;
                u32x4 w; w.x = cvt_pk_bf16(orr[0], orr[1]); w.y = cvt_pk_bf16(orr[2], orr[3]); w.z = cvt_pk_bf16(orr[4], orr[5]); w.w = cvt_pk_bf16(orr[6], orr[7]); *(u32x4*)dst = w;
                w.x = cvt_pk_bf16(oi[0], oi[1]); w.y = cvt_pk_bf16(oi[2], oi[3]); w.z = cvt_pk_bf16(oi[4], oi[5]); w.w = cvt_pk_bf16(oi[6], oi[7]); *(u32x4*)(dst + 64) = w; } }
    }
};
struct EpiFFT2 {
    static constexpr bool PERM = false, AFTER_DRAIN = false;
    bf16_t* MIXp; float scale;
    __device__ __forceinline__ void operator()(const f32x4 (&acc)[2][2][4][2], const Unit& u, int wr, int wc, int fr, int fq) const {
        asm volatile("" : "+v"(fr), "+v"(fq));
        if (wc < 2) {
#pragma unroll
            for (int ai = 0; ai < 2; ++ai)
#pragma unroll
                for (int mi = 0; mi < 4; ++mi) { const int r = u.pm * BM + 128 * ai + 64 * wr + 16 * mi + fr, b = r >> 16, l2p = (r >> 9) & 127, ng = r & 511;
                    bf16_t* base = MIXp + ((size_t)(b * 8192 + l2p)) * 2048 + 1536 + ng;
#pragma unroll
                    for (int n = 0; n < 2; ++n)
#pragma unroll
                        for (int j = 0; j < 4; ++j) { const int l1p = 32 * wc + 16 * n + 4 * fq + j;
                            base[(size_t)l1p * 128 * 2048] = (bf16_t)(cvt_pk_bf16(acc[ai][0][mi][n][j] * scale, 0.0f) & 0xffffu); } }
        }
    }
};

template <class Epi, class Sched, bool ALIGN_EPI = false, bool SP2 = false>
__device__ __forceinline__ void gemm_phase(PG8_LAS unsigned char* lds, const Gemm g, const Sched& S, const Epi& E, const int tid) {
    const int wid = __builtin_amdgcn_readfirstlane(tid >> 6), lane = tid & 63, wr = wid >> 2, wc = wid & 3, fr = lane & 15, fq = lane >> 4;
    const int K = g.K; int nt = K / BK;
    unsigned voffA[2], voffB[2];
#pragma unroll
    for (int i = 0; i < 2; ++i) { int R, C; stage_rc(tid * 16 + i * 8192, R, C); const int Rb = Epi::PERM ? ((R & ~31) + perm32(R & 31)) : R;
        voffA[i] = (unsigned)(R * g.lda + C) * 2u; voffB[i] = (unsigned)(Rb * g.ldb + C) * 2u; }
    const size_t kstep = (size_t)(BK * 2);
    const size_t hstepA = (size_t)HALF * g.lda * 2, hstepB = (size_t)HALF * g.ldb * 2;
    const size_t tstepA = 2 * hstepA, tstepB = 2 * hstepB;
    const unsigned ldsw = (unsigned)wid * 1024u;
    const int aoff = lds_byte(wr * 64 + fr, fq * 8), boff = lds_byte(wc * 32 + fr, fq * 8);
#define PG8_SA(b, h) (((b) * 2 + (h)) * HTB)
#define PG8_SB(b, h) ((4 + (b) * 2 + (h)) * HTB)
#define PG8_STAGE(bufoff, gbase, voff) do { _Pragma("unroll") for (int _i = 0; _i < 2; ++_i) \
        __builtin_amdgcn_global_load_lds((const unsigned*)((const char*)(gbase) + (voff)[_i]), (PG8_LAS unsigned*)(lds + (bufoff) + ldsw + _i * 8192), 16, 0, 0); } while (0)
#define PG8_LDA(dst, b, h) do { _Pragma("unroll") for (int m = 0; m < 4; ++m) _Pragma("unroll") for (int k = 0; k < 2; ++k) dst[m][k] = *(const PG8_LAS bf16x8*)(lds + PG8_SA(b, h) + aoff + m * 2048 + k * 1024); } while (0)
#define PG8_LDB(dst, b, h) do { _Pragma("unroll") for (int n = 0; n < 2; ++n) _Pragma("unroll") for (int k = 0; k < 2; ++k) dst[n][k] = *(const PG8_LAS bf16x8*)(lds + PG8_SB(b, h) + boff + n * 2048 + k * 1024); } while (0)
#define PG8_MMA(ai, bj, At, Bt) do { __builtin_amdgcn_s_setprio(1); _Pragma("unroll") for (int m = 0; m < 4; ++m) _Pragma("unroll") for (int n = 0; n < 2; ++n) _Pragma("unroll") for (int k = 0; k < 2; ++k) \
        acc[ai][bj][m][n] = __builtin_amdgcn_mfma_f32_16x16x32_bf16(Bt[n][k], At[m][k], acc[ai][bj][m][n], 0, 0, 0); __builtin_amdgcn_s_setprio(0); } while (0)
#define PG8_WAIT_V(n) asm volatile("s_waitcnt vmcnt(" #n ")" ::: "memory")
#define PG8_WAIT_L(n) asm volatile("s_waitcnt lgkmcnt(" #n ")" ::: "memory")
#define PG8_BAR __builtin_amdgcn_s_barrier()
#define PG8_SCHED __builtin_amdgcn_sched_barrier(0)
    Unit cur, nxt; int ui = 0;
    if (!S.next(0, cur)) return;
    f32x4 acc[2][2][4][2];
#pragma unroll
    for (int a = 0; a < 2; ++a)
#pragma unroll
        for (int b = 0; b < 2; ++b)
#pragma unroll
            for (int m = 0; m < 4; ++m)
#pragma unroll
                for (int n = 0; n < 2; ++n) acc[a][b][m][n] = (f32x4){0.f, 0.f, 0.f, 0.f};
    bf16x8 At[4][2], B0[2][2], B1[2][2];
    const char* cA = (const char*)g.A + (size_t)cur.pm * tstepA; const char* cB = (const char*)g.Bt + (size_t)(cur.pn & 255) * tstepB;
    if constexpr (Sched::SPLIT) { const int ks1 = cur.pn >> 8; if (ks1) { cA += (size_t)(ks1 - 1) * S.nkt * kstep; cB += (size_t)(ks1 - 1) * S.nkt * kstep; nt = S.nkt; } }
    S.a_ready(cur);
    if constexpr (SP2) {
        PG8_STAGE(PG8_SB(0, 0), cB, voffB); PG8_STAGE(PG8_SB(0, 1), cB + hstepB, voffB); PG8_STAGE(PG8_SA(0, 0), cA, voffA); PG8_STAGE(PG8_SA(0, 1), cA + hstepA, voffA);
        if (wr == 1) PG8_BAR;
        PG8_WAIT_V(2); PG8_BAR;
        PG8_STAGE(PG8_SB(1, 0), cB + kstep, voffB); PG8_STAGE(PG8_SA(1, 0), cA + kstep, voffA); PG8_STAGE(PG8_SB(1, 1), cB + hstepB + kstep, voffB);
        PG8_WAIT_V(6); PG8_BAR;
    } else {
        PG8_STAGE(PG8_SB(0, 0), cB, voffB); PG8_STAGE(PG8_SA(0, 0), cA, voffA); PG8_STAGE(PG8_SB(0, 1), cB + hstepB, voffB); PG8_STAGE(PG8_SA(0, 1), cA + hstepA, voffA);
        if (wr == 1) PG8_BAR;
        PG8_WAIT_V(4); PG8_BAR;
        PG8_STAGE(PG8_SB(1, 0), cB + kstep, voffB); PG8_STAGE(PG8_SA(1, 0), cA + kstep, voffA); PG8_STAGE(PG8_SB(1, 1), cB + hstepB + kstep, voffB);
        PG8_WAIT_V(6); PG8_BAR;
    }
    for (;;) {
        const bool has_next = S.next(ui + 1, nxt);
        const char* nA = has_next ? (const char*)g.A + (size_t)nxt.pm * tstepA : cA; const char* nB = has_next ? (const char*)g.Bt + (size_t)(nxt.pn & 255) * tstepB : cB;
        if constexpr (Sched::SPLIT) { const int ks1 = has_next ? (nxt.pn >> 8) : 0; if (ks1) { nA += (size_t)(ks1 - 1) * S.nkt * kstep; nB += (size_t)(ks1 - 1) * S.nkt * kstep; } }
#pragma clang loop unroll(disable)
        for (int t = 0; t < nt; t += 2) {
            const bool last = (t == nt - 2);
            const char* a1 = cA + (size_t)(t + 1) * kstep;
            const char* a2 = last ? nA : cA + (size_t)(t + 2) * kstep; const char* b2 = last ? nB : cB + (size_t)(t + 2) * kstep;
            const char* a3 = a2 + kstep; const char* b3 = b2 + kstep;
            if (last && has_next) S.a_ready(nxt);
            if constexpr (SP2) {
            PG8_LDB(B0, 0, 0); PG8_LDB(B1, 0, 1); PG8_SCHED; PG8_LDA(At, 0, 0); PG8_STAGE(PG8_SA(1, 1), a1 + hstepA, voffA);
            PG8_WAIT_V(8); PG8_WAIT_L(0); PG8_BAR; PG8_MMA(0, 0, At, B0); PG8_MMA(0, 1, At, B1); PG8_BAR; PG8_SCHED;
            PG8_LDA(At, 0, 1); PG8_STAGE(PG8_SB(0, 0), b2, voffB); PG8_STAGE(PG8_SB(0, 1), b2 + hstepB, voffB); PG8_STAGE(PG8_SA(0, 0), a2, voffA);
            PG8_WAIT_V(8); PG8_WAIT_L(0); PG8_BAR; PG8_MMA(1, 0, At, B0); PG8_MMA(1, 1, At, B1); PG8_BAR; PG8_SCHED;
            PG8_LDB(B0, 1, 0); PG8_LDB(B1, 1, 1); PG8_SCHED; PG8_LDA(At, 1, 0); PG8_STAGE(PG8_SA(0, 1), a2 + hstepA, voffA);
            PG8_WAIT_V(8); PG8_WAIT_L(0); PG8_BAR; PG8_MMA(0, 0, At, B0); PG8_MMA(0, 1, At, B1); PG8_BAR; PG8_SCHED;
            PG8_LDA(At, 1, 1); PG8_STAGE(PG8_SB(1, 0), b3, voffB); PG8_STAGE(PG8_SB(1, 1), b3 + hstepB, voffB); PG8_STAGE(PG8_SA(1, 0), a3, voffA);
            PG8_WAIT_V(8); PG8_WAIT_L(0); PG8_BAR; PG8_MMA(1, 0, At, B0); PG8_MMA(1, 1, At, B1); PG8_BAR; PG8_SCHED;
            } else {
            PG8_LDB(B0, 0, 0); PG8_SCHED; PG8_LDA(At, 0, 0); PG8_STAGE(PG8_SA(1, 1), a1 + hstepA, voffA);
            PG8_WAIT_L(8); PG8_BAR; PG8_WAIT_L(0); PG8_MMA(0, 0, At, B0); PG8_BAR; PG8_SCHED;
            PG8_LDB(B1, 0, 1); PG8_STAGE(PG8_SB(0, 0), b2, voffB);
            PG8_BAR; PG8_WAIT_L(0); PG8_MMA(0, 1, At, B1); PG8_BAR;
            PG8_LDA(At, 0, 1); PG8_STAGE(PG8_SA(0, 0), a2, voffA);
            PG8_BAR; PG8_WAIT_L(0); PG8_MMA(1, 0, At, B0); PG8_BAR; PG8_SCHED;
            PG8_STAGE(PG8_SB(0, 1), b2 + hstepB, voffB);
            PG8_WAIT_V(6); PG8_BAR; PG8_MMA(1, 1, At, B1); PG8_BAR;
            PG8_LDB(B0, 1, 0); PG8_SCHED; PG8_LDA(At, 1, 0); PG8_STAGE(PG8_SA(0, 1), a2 + hstepA, voffA);
            PG8_WAIT_L(8); PG8_BAR; PG8_WAIT_L(0); PG8_MMA(0, 0, At, B0); PG8_BAR; PG8_SCHED;
            PG8_LDB(B1, 1, 1); PG8_STAGE(PG8_SB(1, 0), b3, voffB);
            PG8_BAR; PG8_WAIT_L(0); PG8_MMA(0, 1, At, B1); PG8_BAR;
            PG8_LDA(At, 1, 1); PG8_STAGE(PG8_SA(1, 0), a3, voffA);
            PG8_BAR; PG8_WAIT_L(0); PG8_MMA(1, 0, At, B0); PG8_BAR; PG8_SCHED;
            PG8_STAGE(PG8_SB(1, 1), b3 + hstepB, voffB);
            PG8_WAIT_V(6); PG8_BAR; PG8_MMA(1, 1, At, B1); PG8_BAR;
            }
        }
        if constexpr (ALIGN_EPI) { if (wr == 0) PG8_BAR; }
        if constexpr (!Epi::AFTER_DRAIN) { E(acc, cur, wr, wc, fr, fq); S.done(cur); }
        if (!has_next) break;
#pragma unroll
        for (int a = 0; a < 2; ++a)
#pragma unroll
            for (int b = 0; b < 2; ++b)
#pragma unroll
                for (int m = 0; m < 4; ++m)
#pragma unroll
                    for (int n = 0; n < 2; ++n) acc[a][b][m][n] = (f32x4){0.f, 0.f, 0.f, 0.f};
        cur = nxt; cA = nA; cB = nB; ++ui; if constexpr (Sched::SPLIT) nt = (cur.pn >> 8) ? S.nkt : S.ntfull;
        if constexpr (ALIGN_EPI) { if (wr == 1) PG8_BAR; }
    }
    PG8_WAIT_V(0);
    if constexpr (!ALIGN_EPI) { if (wr == 0) PG8_BAR; }
    PG8_BAR;
#undef PG8_SA
#undef PG8_SB
#undef PG8_STAGE
#undef PG8_LDA
#undef PG8_LDB
#undef PG8_MMA
#undef PG8_WAIT_V
#undef PG8_WAIT_L
#undef PG8_BAR
#undef PG8_SCHED
}
}

constexpr int NWAVES = 8;
constexpr int DM = 2048, SEQ = 8192, NB = 2, DEPTH = 4, CTX = 256, HD = 64, NH = 16;
constexpr int DR = 1024, DC = 512, DF = 512;
constexpr int R0 = 0, K0 = 1024, V0 = 2048, WD0 = 3072, AD0 = 3168, GD0 = 3264, RWC = 3520;
constexpr int CG0 = 3520, CX0 = 4032, CB0 = 4544, FT0 = 5056, DIN = 5568, DINP = 5632;
constexpr int DFF = 5632;
constexpr int ML = NB * SEQ, MC = NB * CTX, MR = ML + MC;
constexpr int MODW = 6 * DM;
constexpr float RMS_EPS = 1e-6f, GN_EPS = 64e-5f, KK_EPS = 1e-12f;

constexpr size_t MiB = 1u << 20;
constexpr size_t WS_CTL = 0, CTL_ZERO_BYTES = 1 * MiB;
constexpr size_t WS_MOD = 1 * MiB;
constexpr size_t WS_MODP = 2 * MiB;
constexpr size_t WS_BONUS = 8 * MiB;
constexpr size_t WS_LA = 10 * MiB;
constexpr size_t WS_DFTC = 28 * MiB;
constexpr size_t WS_FTC = 29 * MiB;
constexpr size_t WS_WL1 = 30 * MiB;
constexpr size_t WS_WG = 32 * MiB;
constexpr size_t WS_X = 34 * MiB;
constexpr size_t WS_WIN = WS_X + 132 * MiB;
constexpr size_t WS_WOUT = WS_WIN + 22 * MiB;
constexpr size_t WS_WGU = WS_WOUT + 8 * MiB;
constexpr size_t WS_WDN = WS_WGU + 44 * MiB;
constexpr size_t WS_F1 = 33 * MiB;
constexpr size_t WS_F2 = 33 * MiB + 256 * 1024;
constexpr size_t WS_WSET = 96 * MiB;
constexpr size_t WS_R0 = WS_WDN + 22 * MiB + WS_WSET;
constexpr size_t HMiB = MiB / 2;
constexpr size_t WS_XN = WS_R0;
constexpr size_t WS_RS = WS_R0, WS_KK = WS_R0 + 33 * MiB;
constexpr size_t WS_H = WS_R0 + 66 * MiB;
constexpr size_t WS_PX = WS_H;
constexpr size_t WS_SCR1 = WS_R0 + 858 * MiB;
constexpr size_t WS_AA = WS_R0 + 495 * HMiB;
constexpr size_t WS_LW = WS_R0 + 627 * HMiB;
constexpr size_t WS_YF = WS_LW + 99 * MiB, WS_YB = WS_LW + 66 * MiB;
constexpr size_t WS_KD = WS_R0 + 891 * HMiB;
constexpr size_t WS_BH = WS_KD + 66 * MiB;
constexpr size_t WS_VS = WS_BH + 66 * MiB;
constexpr size_t WS_G = WS_VS + 33 * MiB;
constexpr size_t WS_MIX = WS_G + 33 * MiB;
constexpr size_t WS_SCR3 = WS_MIX + 66 * MiB;
constexpr size_t WS_D1 = WS_SCR3 + 17 * MiB;
constexpr size_t WS_D2 = WS_D1 + 32 * MiB;
constexpr size_t WS_PARTH = WS_SCR3 + 82 * MiB;
constexpr size_t WS_PARTK = WS_SCR3 + 98 * MiB;
constexpr size_t WS_COMP = WS_SCR3 + 114 * MiB;
constexpr size_t WS_END = WS_SCR1 + 495 * HMiB;
constexpr int NCH = 132;
constexpr int NSEG = 4, SEGLEN = NCH / NSEG;
constexpr size_t ITEM_BYTES = 32768;
constexpr int SCR1_ITEMS = 7920;
static_assert((size_t)SCR1_ITEMS * ITEM_BYTES == 495 * HMiB && (size_t)(64 * NCH - SCR1_ITEMS) * ITEM_BYTES <= 297 * HMiB, "scan scratch");
static_assert((size_t)MR * 2048 * 4 == 132 * MiB && (size_t)MR * 5632 * 2 <= 182 * MiB, "sizes");

constexpr size_t SCAN_FLAG_OFF = 65536;
constexpr int CW_BAR = 4096;

constexpr int RING_OFF = 0, RING_BYTES = 131072;
constexpr int LDSCTL_OFF = 139264, MISC_OFF = LDSCTL_OFF + 320;
constexpr int LDS_BYTES = 147456;

#define GAS __attribute__((address_space(1)))
#define LAS __attribute__((address_space(3)))
typedef unsigned short bf16;
typedef unsigned v4u __attribute__((ext_vector_type(4)));
typedef unsigned v2u __attribute__((ext_vector_type(2)));
typedef float f32x4 __attribute__((ext_vector_type(4)));
#define LDS_WAIT() asm volatile("s_waitcnt lgkmcnt(0)" ::: "memory")
#define VM_WAIT() asm volatile("s_waitcnt vmcnt(0)" ::: "memory")
__device__ __forceinline__ unsigned pk2(float lo, float hi) { return pg8::cvt_pk_bf16(lo, hi); }
__device__ __forceinline__ unsigned f2bf(float f) { return pg8::cvt_pk_bf16(f, 0.0f) & 0xffffu; }
__device__ __forceinline__ float bflo(unsigned w) { return __uint_as_float(w << 16); }
__device__ __forceinline__ float bfhi(unsigned w) { return __uint_as_float(w & 0xffff0000u); }
__device__ __forceinline__ float bf1(bf16 b) { return __uint_as_float(((unsigned)b) << 16); }
__device__ __forceinline__ void unpack8(const v4u w, float (&f)[8]) { f[0] = bflo(w.x); f[1] = bfhi(w.x); f[2] = bflo(w.y); f[3] = bfhi(w.y); f[4] = bflo(w.z); f[5] = bfhi(w.z); f[6] = bflo(w.w); f[7] = bfhi(w.w); }
__device__ __forceinline__ v4u pack8(const float (&f)[8]) { v4u w; w.x = pk2(f[0], f[1]); w.y = pk2(f[2], f[3]); w.z = pk2(f[4], f[5]); w.w = pk2(f[6], f[7]); return w; }
__device__ __forceinline__ float sigm(float x) { return __builtin_amdgcn_rcpf(1.0f + __expf(-x)); }
__device__ __forceinline__ float tanh_(float x) { return 1.0f - 2.0f * __builtin_amdgcn_rcpf(1.0f + __expf(2.0f * x)); }

#define XB_TMO      128
#define XB_XCNT(j)  (256  + 64 * (j))
#define XB_XSUB(j)  (1280 + 64 * (j))
#define XB_XGEN(j)  (2304 + 64 * (j))
#define XB_TOP      3328
#define XB_TOPGEN   3392
#define XCD_BAR_WORDS 3456
#define XB_SPIN_CAP (1u << 20)

__device__ __forceinline__ unsigned xb_ld(unsigned* p)              { return __hip_atomic_load(p, __ATOMIC_RELAXED, __HIP_MEMORY_SCOPE_AGENT); }
__device__ __forceinline__ unsigned xb_add(unsigned* p, unsigned v) { return __hip_atomic_fetch_add(p, v, __ATOMIC_RELAXED, __HIP_MEMORY_SCOPE_AGENT); }
__device__ __forceinline__ unsigned xb_xcc_id() { return (unsigned)__builtin_amdgcn_s_getreg((3 << 11) | 20) & 0xFu; }
#define XB_SPIN(cond, bar) do { unsigned _sp = 0; while (cond) { __builtin_amdgcn_s_sleep(1); \
    if ((++_sp & 255u) == 0u) { if (xb_ld(&(bar)[XB_TMO])) break; if (_sp > XB_SPIN_CAP) { atomicAdd(&(bar)[XB_TMO], 1u); break; } } } } while (0)

struct XcdBarrier { unsigned* bar; unsigned x; volatile LAS unsigned* st; };
__device__ __forceinline__ XcdBarrier xcd_barrier_post(unsigned* bar, volatile LAS unsigned* st) {
    XcdBarrier b; b.bar = bar; b.x = xb_xcc_id(); b.st = st;
    if (threadIdx.x == 0) (void)xb_add(&bar[XB_XCNT(b.x)], 1u);
    return b;
}
__device__ __forceinline__ void xcd_barrier_complete(unsigned* bar, unsigned x, unsigned& nloc, unsigned& nx) {
    const unsigned G = gridDim.x * gridDim.y * gridDim.z;
    unsigned sum, cnt, mine, sp = 0u;
    for (;;) {
        sum = 0u; cnt = 0u; mine = 0u;
#pragma unroll
        for (unsigned j = 0; j < 16; ++j) { const unsigned c = xb_ld(&bar[XB_XCNT(j)]); sum += c; cnt += (c > 0u) ? 1u : 0u; mine = (j == x) ? c : mine; }
        if (sum == G) break;
        __builtin_amdgcn_s_sleep(1);
        if ((++sp & 255u) == 0u) { if (xb_ld(&bar[XB_TMO])) break; if (sp > XB_SPIN_CAP) { atomicAdd(&bar[XB_TMO], 1u); break; } }
    }
    nloc = mine > 0u ? mine : 1u; nx = cnt > 0u ? cnt : 1u;
}
__device__ __forceinline__ void xcd_barrier(const XcdBarrier& b) {
    asm volatile("s_waitcnt vmcnt(0)" ::: "memory");
    __syncthreads();
    if (threadIdx.x == 0) {
        unsigned* bar = b.bar;
        __builtin_amdgcn_s_waitcnt(0);
        unsigned nloc = b.st[0], nx = b.st[1];
        if (nloc == 0u) { xcd_barrier_complete(bar, b.x, nloc, nx); b.st[0] = nloc; b.st[1] = nx; }
        const unsigned old = xb_add(&bar[XB_XSUB(b.x)], 1u);
        const unsigned gen = old / nloc;
        if (old + 1u == (gen + 1u) * nloc) {
            __builtin_amdgcn_fence(__ATOMIC_RELEASE, "agent");
            asm volatile("s_waitcnt vmcnt(0)" ::: "memory");
            const unsigned og = xb_add(&bar[XB_TOP], 1u);
            const unsigned tg = og / nx;
            if (og + 1u == (tg + 1u) * nx) xb_add(&bar[XB_TOPGEN], 1u);
            else XB_SPIN(xb_ld(&bar[XB_TOPGEN]) == tg, bar);
            __builtin_amdgcn_fence(__ATOMIC_ACQUIRE, "agent");
            xb_add(&bar[XB_XGEN(b.x)], 1u);
            asm volatile("s_waitcnt vmcnt(0)" ::: "memory");
        } else {
            XB_SPIN(xb_ld(&bar[XB_XGEN(b.x)]) == gen, bar);
            __builtin_amdgcn_fence(__ATOMIC_ACQUIRE, "agent");
            asm volatile("s_waitcnt vmcnt(0)" ::: "memory");
        }
    }
    __syncthreads();
}

__device__ __forceinline__ float shx(float v, int lane, int o) { return __uint_as_float(__builtin_amdgcn_ds_bpermute((lane ^ o) << 2, __float_as_uint(v))); }
__device__ __forceinline__ float wave_sum(float v, int lane) {
#pragma unroll
    for (int o = 1; o < 64; o <<= 1) v += shx(v, lane, o);
    return v;
}
__device__ __forceinline__ float sum16(float v, int lane) {
#pragma unroll
    for (int o = 1; o < 16; o <<= 1) v += shx(v, lane, o);
    return v;
}
__device__ __forceinline__ void row_seg(int r, int& t, int& len) { if (r < ML) { t = r & (SEQ - 1); len = SEQ; } else { t = (r - ML) & (CTX - 1); len = CTX; } }

__device__ __forceinline__ void transpose_item(const float* W, int N, bf16* WT, int ldk, int k0, int n0, int drow0, LAS float* scr, int lane) {
    float tv_[32];
    const float* wp_ = W + (size_t)(k0 + (lane >> 5)) * N + n0 + (lane & 31);
#pragma unroll
    for (int i = 0; i < 32; ++i) tv_[i] = __builtin_nontemporal_load(wp_ + (size_t)(2 * i) * N);
#pragma unroll
    for (int i = 0; i < 32; ++i) scr[(2 * i + (lane >> 5)) * 33 + (lane & 31)] = tv_[i];
    LDS_WAIT(); asm volatile("" ::: "memory");
    const int c = lane & 7;
#pragma unroll
    for (int j = 0; j < 4; ++j) { const int n = (lane >> 3) + 8 * j; const LAS float* s = scr + (8 * c) * 33 + n;
        v4u o; o.x = pk2(s[0 * 33], s[1 * 33]); o.y = pk2(s[2 * 33], s[3 * 33]); o.z = pk2(s[4 * 33], s[5 * 33]); o.w = pk2(s[6 * 33], s[7 * 33]);
        *(v4u*)(WT + (size_t)(drow0 + n) * ldk + k0 + 8 * c) = o; }
    LDS_WAIT(); asm volatile("" ::: "memory");
}

__device__ __forceinline__ void norm_row_bf16(const float* xrow, const float* g, const float* shift, const float* scale, bf16* orow, int lane) {
    const f32x4* xr = (const f32x4*)xrow + lane;
    f32x4 v[8]; float s = 0.f;
#pragma unroll
    for (int j = 0; j < 8; ++j) { v[j] = xr[64 * j]; s += (v[j].x * v[j].x + v[j].y * v[j].y) + (v[j].z * v[j].z + v[j].w * v[j].w); }
    const float rstd = 1.0f / sqrtf(wave_sum(s, lane) * (1.0f / DM) + RMS_EPS);
    unsigned long long* o8 = (unsigned long long*)orow + lane;
#pragma unroll
    for (int j = 0; j < 8; ++j) { const int c4 = 64 * j + lane;
        const f32x4 gg = ((const f32x4*)g)[c4], sh = ((const f32x4*)shift)[c4], sc = ((const f32x4*)scale)[c4];
        f32x4 y = v[j] * rstd * gg; y = y * (1.0f + sc) + sh;
        o8[64 * j] = (unsigned long long)pk2(y.x, y.y) | ((unsigned long long)pk2(y.z, y.w) << 32); }
}

__device__ __forceinline__ pg8::bf16x8 ldf(LAS const unsigned char* buf, int rb, int ks, int g, int c) { return *(LAS const pg8::bf16x8*)(buf + (16 * rb + c) * 144 + (32 * ks + 8 * g) * 2); }
__device__ __forceinline__ f32x4 mm(LAS const unsigned char* A, int ra, LAS const unsigned char* B, int rbk, int g, int c, f32x4 acc) {
    acc = __builtin_amdgcn_mfma_f32_16x16x32_bf16(ldf(A, ra, 0, g, c), ldf(B, rbk, 0, g, c), acc, 0, 0, 0);
    acc = __builtin_amdgcn_mfma_f32_16x16x32_bf16(ldf(A, ra, 1, g, c), ldf(B, rbk, 1, g, c), acc, 0, 0, 0);
    return acc; }
__device__ __forceinline__ float wave_incl_scan(float v) {
#define DPP_ADD(ctrl, rmask, bc) v += __uint_as_float(__builtin_amdgcn_update_dpp(0u, __float_as_uint(v), (ctrl), (rmask), 0xf, (bc)))
    DPP_ADD(0x111, 0xf, true); DPP_ADD(0x112, 0xf, true); DPP_ADD(0x114, 0xf, true); DPP_ADD(0x118, 0xf, true);
    DPP_ADD(0x142, 0xa, false); DPP_ADD(0x143, 0xc, false);
#undef DPP_ADD
    return v;
}
struct Fr2 { pg8::bf16x8 k0, k1; };
__device__ __forceinline__ Fr2 ldf2(LAS const unsigned char* buf, int rb, int g, int c) { Fr2 f; f.k0 = ldf(buf, rb, 0, g, c); f.k1 = ldf(buf, rb, 1, g, c); return f; }
__device__ __forceinline__ f32x4 mmf(const Fr2& A, const Fr2& B, f32x4 acc) {
    acc = __builtin_amdgcn_mfma_f32_16x16x32_bf16(A.k0, B.k0, acc, 0, 0, 0); acc = __builtin_amdgcn_mfma_f32_16x16x32_bf16(A.k1, B.k1, acc, 0, 0, 0); return acc; }
__device__ __forceinline__ Fr2 ldf2_tr(LAS const unsigned char* buf, int rb, int g, int c) {
    typedef short s4_t __attribute__((ext_vector_type(4)));
    LAS const unsigned char* p = buf + (8 * g + (c >> 2)) * 144 + (16 * rb + 4 * (c & 3)) * 2;
    const s4_t a0 = __builtin_amdgcn_ds_read_tr16_b64_v4i16((LAS s4_t*)(p)), a1 = __builtin_amdgcn_ds_read_tr16_b64_v4i16((LAS s4_t*)(p + 4 * 144));
    const s4_t b0 = __builtin_amdgcn_ds_read_tr16_b64_v4i16((LAS s4_t*)(p + 32 * 144)), b1 = __builtin_amdgcn_ds_read_tr16_b64_v4i16((LAS s4_t*)(p + 36 * 144));
    Fr2 f; f.k0 = __builtin_shufflevector(a0, a1, 0, 1, 2, 3, 4, 5, 6, 7); f.k1 = __builtin_shufflevector(b0, b1, 0, 1, 2, 3, 4, 5, 6, 7); return f;
}
__device__ __forceinline__ pg8::bf16x8 ldf_tr(LAS const unsigned char* buf, int rb, int ks, int g, int c) {
    typedef short s4_t __attribute__((ext_vector_type(4)));
    LAS const unsigned char* p = buf + (32 * ks + 8 * g + (c >> 2)) * 144 + (16 * rb + 4 * (c & 3)) * 2;
    const s4_t a0 = __builtin_amdgcn_ds_read_tr16_b64_v4i16((LAS s4_t*)(p)), a1 = __builtin_amdgcn_ds_read_tr16_b64_v4i16((LAS s4_t*)(p + 4 * 144));
    return __builtin_shufflevector(a0, a1, 0, 1, 2, 3, 4, 5, 6, 7);
}
__device__ __forceinline__ v2u pack4(f32x4 a) { v2u w; w.x = pg8::cvt_pk_bf16(a[0], a[1]); w.y = pg8::cvt_pk_bf16(a[2], a[3]); return w; }
__device__ __forceinline__ void st_nat(LAS unsigned char* buf, int mt, int nt, int g, int c, f32x4 a) { *(LAS v2u*)(buf + (16 * mt + c) * 144 + (16 * nt + 4 * g) * 2) = pack4(a); }
__device__ __forceinline__ void st_tr(LAS unsigned char* buf, int mt, int nt, int g, int c, f32x4 a) { *(LAS v2u*)(buf + (16 * nt + c) * 144 + (16 * mt + 4 * g) * 2) = pack4(a); }

__device__ __forceinline__ void ctx_row_add_partials(unsigned short* xrow, const float* xsrc32, const float* prow, const float* gatev, int lane) {
#pragma unroll
    for (int jj = 0; jj < 4; ++jj) { const int c8 = 8 * (64 * jj + lane); float xv[8]; f32x4 s0 = *(const f32x4*)(prow + c8), s1 = *(const f32x4*)(prow + c8 + 4);
#pragma unroll
        for (int ks = 1; ks < 4; ++ks) { s0 += *(const f32x4*)(prow + (size_t)ks * 512 * 2048 + c8); s1 += *(const f32x4*)(prow + (size_t)ks * 512 * 2048 + c8 + 4); }
        if (xsrc32) { const f32x4 a0 = *(const f32x4*)(xsrc32 + c8), a1 = *(const f32x4*)(xsrc32 + c8 + 4); xv[0] = a0[0]; xv[1] = a0[1]; xv[2] = a0[2]; xv[3] = a0[3]; xv[4] = a1[0]; xv[5] = a1[1]; xv[6] = a1[2]; xv[7] = a1[3]; }
        else pg8::unpack_h8(*(const v4u*)(xrow + c8), xv);
        const f32x4 g0 = *(const f32x4*)(gatev + c8), g1 = *(const f32x4*)(gatev + c8 + 4);
#pragma unroll
        for (int e = 0; e < 4; ++e) { xv[e] += g0[e] * s0[e]; xv[4 + e] += g1[e] * s1[e]; }
        *(v4u*)(xrow + c8) = pg8::pack_h8(xv); }
}

#define NORM_ROWS(gptr, sh_off, sc_off, X32, PARTCALL) do { \
    for (int j_ = 0; j_ < 3; ++j_) { const float* mv_ = MODL + (size_t)j_ * MODW; f32x4 gg_[4][2], shv_[4][2]; \
        _Pragma("unroll") for (int jj = 0; jj < 4; ++jj) _Pragma("unroll") for (int hh = 0; hh < 2; ++hh) { const int c4 = 8 * (64 * jj + lane) + 4 * hh; \
            gg_[jj][hh] = *(const f32x4*)((gptr) + c4) * (1.0f + *(const f32x4*)(mv_ + (sc_off) + c4)); shv_[jj][hh] = *(const f32x4*)(mv_ + (sh_off) + c4); } \
        const int r0_ = j_ == 0 ? 0 : (j_ == 1 ? SEQ : ML), r1_ = j_ == 0 ? SEQ : (j_ == 1 ? ML : MR); \
        for (int ra_ = r0_ + gw; ra_ < r1_; ra_ += 2 * NGW) {        \
            const bool vb_ = ra_ + NGW < r1_; \
            { const int r = ra_; PARTCALL; } if (vb_) { const int r = ra_ + NGW; PARTCALL; } \
            float v_[2][4][8]; bool is32_; { const int r = ra_; is32_ = (X32) != nullptr; } \
            if (is32_) { \
                _Pragma("unroll") for (int i_ = 0; i_ < 2; ++i_) { const int r = vb_ ? ra_ + i_ * NGW : ra_; const float* x32_ = (X32); \
                    _Pragma("unroll") for (int jj = 0; jj < 4; ++jj) { const int c8 = 8 * (64 * jj + lane); const f32x4 a0 = *(const f32x4*)(x32_ + c8), a1 = *(const f32x4*)(x32_ + c8 + 4); \
                        v_[i_][jj][0] = a0[0]; v_[i_][jj][1] = a0[1]; v_[i_][jj][2] = a0[2]; v_[i_][jj][3] = a0[3]; v_[i_][jj][4] = a1[0]; v_[i_][jj][5] = a1[1]; v_[i_][jj][6] = a1[2]; v_[i_][jj][7] = a1[3]; } } \
            } else { v4u w16_[2][4]; \
                _Pragma("unroll") for (int i_ = 0; i_ < 2; ++i_) { const int r = vb_ ? ra_ + i_ * NGW : ra_; const unsigned short* x16_ = W_(unsigned short, WS_X) + (size_t)r * DM; \
                    _Pragma("unroll") for (int jj = 0; jj < 4; ++jj) w16_[i_][jj] = *(const v4u*)(x16_ + 8 * (64 * jj + lane)); } \
                _Pragma("unroll") for (int i_ = 0; i_ < 2; ++i_) _Pragma("unroll") for (int jj = 0; jj < 4; ++jj) pg8::unpack_h8(w16_[i_][jj], v_[i_][jj]); } \
            _Pragma("unroll") for (int i_ = 0; i_ < 2; ++i_) { const int r = ra_ + i_ * NGW; float s_ = 0.f; \
                _Pragma("unroll") for (int jj = 0; jj < 4; ++jj) _Pragma("unroll") for (int e = 0; e < 8; ++e) s_ += v_[i_][jj][e] * v_[i_][jj][e]; \
                const float rstd_ = 1.0f / sqrtf(wave_sum(s_, lane) * (1.0f / DM) + RMS_EPS); \
                if (i_ == 0 || vb_) { bf16* o_ = W_(bf16, WS_XN) + (size_t)r * DM; \
                    _Pragma("unroll") for (int jj = 0; jj < 4; ++jj) { float y_[8]; \
                        _Pragma("unroll") for (int e = 0; e < 8; ++e) y_[e] = v_[i_][jj][e] * rstd_ * gg_[jj][e >> 2][e & 3] + shv_[jj][e >> 2][e & 3]; \
                        *(v4u*)(o_ + 8 * (64 * jj + lane)) = pack8(y_); } } } } } } while (0)

constexpr int CVT_NIT = 32 * 174 + 32 * 64 + 2 * 32 * 176 + 88 * 64;
constexpr int CVT_Q1 = 6400, CVT_Q2 = 18900;
#define CONVERT_WEIGHTS(LL, widx, nwk, scr) CONVERT_WEIGHTS_RANGE(LL, 0, CVT_NIT, true, widx, nwk, scr)
#define CONVERT_WEIGHTS_RANGE(LL, it0, it1, zfill, widx, nwk, scr) do { \
    constexpr int I_IN = 32 * 174, I_OUT = 32 * 64, I_G = 32 * 176, I_DN = 88 * 64; constexpr int NIT = I_IN + I_OUT + 2 * I_G + I_DN; \
    const size_t wso = (size_t)((LL) & 1) * WS_WSET; \
    const float* wi = INP(7) + (size_t)(LL) * DM * DIN; const float* wo = INP(20) + (size_t)(LL) * DM * DM; \
    const float* wg = INP(22) + (size_t)(LL) * DM * DFF; const float* wu = INP(23) + (size_t)(LL) * DM * DFF; const float* wd = INP(24) + (size_t)(LL) * DFF * DM; \
    static_assert(NIT == CVT_NIT, "CVT_NIT"); \
    for (int it = (it0) + (widx); it < (it1); it += (nwk)) { int r = it; \
        if (r < I_IN) { const int kb = r / 174, nb = r % 174; transpose_item(wi, DIN, W_(bf16, WS_WIN + wso), DM, 64 * kb, 32 * nb, 32 * nb, scr, lane); continue; } r -= I_IN; \
        if (r < I_OUT) { const int kb = r / 64, nb = r % 64; transpose_item(wo, DM, W_(bf16, WS_WOUT + wso), DM, 64 * kb, 32 * nb, 32 * nb, scr, lane); continue; } r -= I_OUT; \
        if (r < I_G) { const int kb = r / 176, nb = r % 176, n0 = 32 * nb; transpose_item(wg, DFF, W_(bf16, WS_WGU + wso), DM, 64 * kb, n0, (n0 >> 7) * 256 + (n0 & 127), scr, lane); continue; } r -= I_G; \
        if (r < I_G) { const int kb = r / 176, nb = r % 176, n0 = 32 * nb; transpose_item(wu, DFF, W_(bf16, WS_WGU + wso), DM, 64 * kb, n0, (n0 >> 7) * 256 + 128 + (n0 & 127), scr, lane); continue; } r -= I_G; \
        { const int kb = r / 64, nb = r % 64; transpose_item(wd, DM, W_(bf16, WS_WDN + wso), DFF, 64 * kb, 32 * nb, 32 * nb, scr, lane); } } \
    if (zfill) for (int i = (widx) * 64 + lane; i < 64 * DM / 8; i += (nwk) * 64) ((v4u*)(W_(bf16, WS_WIN + wso) + (size_t)DIN * DM))[i] = (v4u){(unsigned)oz, (unsigned)oz, (unsigned)oz, (unsigned)oz}; \
    } while (0)

struct Args { const float* in[26]; float* out; unsigned char* ws; int ph_lo, ph_hi; };
constexpr int PH_PER_LAYER = 13;
constexpr int NPHASES = 2 + DEPTH * PH_PER_LAYER + 1;

__global__ void __launch_bounds__(NWAVES * 64, 2) skel_fwd(Args args) {
    extern __shared__ __attribute__((aligned(16))) unsigned char lds_raw[];
    LAS unsigned char* lds = (LAS unsigned char*)lds_raw;
    volatile LAS unsigned* MISC = (volatile LAS unsigned*)(lds + MISC_OFF);
    const int tid0 = threadIdx.x, G0 = gridDim.x, bx0 = blockIdx.x;
    const int wave0 = __builtin_amdgcn_readfirstlane(tid0 >> 6);
    unsigned char* ws = args.ws;
    for (int u = tid0; u < (LDS_BYTES - LDSCTL_OFF) / 4; u += NWAVES * 64) ((LAS unsigned*)(lds + LDSCTL_OFF))[u] = 0u;
    __syncthreads();
#if MK_ONE_LAUNCH
    XcdBarrier bar = xcd_barrier_post((unsigned*)(ws + WS_CTL) + CW_BAR, MISC + 8);
#define GRID_BAR() xcd_barrier(bar)
#else
#define GRID_BAR() do {} while (0)
#endif
    const int lo = args.ph_lo, hi = args.ph_hi;
#define IN(k) (lo <= (k) && (k) < hi)
#define ENDPH(k) do { if (IN((k)) && IN((k) + 1)) GRID_BAR(); } while (0)

    constexpr size_t DSTR = (size_t)MR * 1024;

#define PH_BEGIN unsigned char* wsp = args.ws; asm volatile("" : "+s"(wsp)); GAS unsigned char* wsg = (GAS unsigned char*)wsp; int oz; asm volatile("s_mov_b32 %0, 0" : "=s"(oz)); \
    int wv_ = wave0, bx = bx0, G = G0; asm volatile("" : "+s"(bx), "+s"(G), "+s"(wv_)); int ln_; asm volatile("v_mbcnt_lo_u32_b32 %0, -1, 0\n\tv_mbcnt_hi_u32_b32 %0, -1, %0" : "=v"(ln_)); int tid = (wv_ << 6) | ln_; \
    const int lane = tid & 63, wave = __builtin_amdgcn_readfirstlane(tid >> 6); \
    const int gw = bx * NWAVES + wave, NGW = G * NWAVES, gt = bx * (NWAVES * 64) + tid, NGT = G * NWAVES * 64; \
    (void)lane; (void)gw; (void)NGW; (void)gt; (void)NGT; (void)oz;
#define W_(T, off) ((T*)(GAS T*)(wsg + (off)))
#define INP(i) ((const float*)(const GAS float*)args.in[(i) + oz])
#define MODL (W_(float, WS_MOD) + (size_t)l * 3 * MODW)
    if (IN(0)) { PH_BEGIN
        LAS float* sl = (LAS float*)lds;
        for (int i = tid; i < 3 * DM; i += NWAVES * 64) { const float v = i < 2 * DM ? INP(1)[i] : INP(3)[i - 2 * DM]; sl[i] = v * sigm(v); }
        __syncthreads();
        for (int it = gw; it < 4 * 48 * 8; it += NGW) {
            const int l = it / 384, rem = it % 384, cg = rem >> 3, ks = rem & 7;
            const float* W = INP(4) + ((size_t)l * DM + ks * 256) * MODW + cg * 256 + lane * 4;
            f32x4 a0 = {0.f, 0.f, 0.f, 0.f}, a1 = a0, a2 = a0;
#pragma unroll 8
            for (int k = 0; k < 256; ++k) { const f32x4 w = __builtin_nontemporal_load((const f32x4*)(W + (size_t)k * MODW));
                a0 += w * sl[ks * 256 + k]; a1 += w * sl[DM + ks * 256 + k]; a2 += w * sl[2 * DM + ks * 256 + k]; }
            float* o = W_(float, WS_MODP) + ((size_t)(ks * 4 + l) * 3) * MODW + cg * 256 + lane * 4;
            *(f32x4*)(o) = a0; *(f32x4*)(o + MODW) = a1; *(f32x4*)(o + 2 * MODW) = a2;
        }
        for (int i = gt; i < 65536; i += NGT) { const int m = i >> 8, k = i & 255, rip = m >> 7, l2p = m & 127, ri = k >> 7, l2 = k & 127;
            const float a = (float)((l2 * l2p) & 127) * (1.0f / 128.0f), cv = __builtin_amdgcn_cosf(a), sv = __builtin_amdgcn_sinf(a);
            W_(bf16, WS_F1)[i] = (bf16)f2bf(rip == ri ? cv : (rip == 0 ? sv : -sv)); }
        for (int i = gt; i < 32768; i += NGT) { const int n = i >> 7, k = i & 127, rip = k >> 6, l1 = k & 63;
            const float a = (float)((l1 * n) & 63) * (1.0f / 64.0f); const float v = n < 64 ? (rip == 0 ? __builtin_amdgcn_cosf(a) : __builtin_amdgcn_sinf(a)) : 0.0f;
            W_(bf16, WS_F2)[i] = (bf16)f2bf(v); }
        for (int i = gt; i < CTX * 512 / 8; i += NGT) {
            const int lp = i >> 6, k0 = (i & 63) * 8; float f[8];
#pragma unroll
            for (int j = 0; j < 8; ++j) { const int k = k0 + j; const int m = (lp * (k & (CTX - 1))) & (CTX - 1); const float a = (float)m * (1.0f / CTX);
                f[j] = k < CTX ? __builtin_amdgcn_cosf(a) : -__builtin_amdgcn_sinf(a); }
            *(v4u*)(W_(bf16, WS_DFTC) + (size_t)i * 8) = pack8(f);
        }
        __syncthreads();
        { LAS float* scr = (LAS float*)(lds + RING_OFF + wave * 16384); CONVERT_WEIGHTS(0, gw, NGW, scr); }
        __syncthreads();
    }
    ENDPH(0);
    if (IN(1)) { PH_BEGIN
        for (int i = gt; i < 4 * 3 * MODW; i += NGT) { const int l = i / (3 * MODW), col = i % MODW; float s = INP(5)[l * MODW + col];
#pragma unroll
            for (int ks = 0; ks < 8; ++ks) s += W_(float, WS_MODP)[(size_t)ks * 4 * 3 * MODW + i];
            W_(float, WS_MOD)[i] = s; }
    }
    ENDPH(1);

#define TAIL_CONVERT(nunits, it0, it1, zfill) do { if (l + 1 < DEPTH) { const int fi_ = (nunits) - ((nunits) - 1) / G * G, first_idle = fi_ >= G ? 0 : fi_; \
    if (bx >= first_idle) { asm volatile("" : "+v"(tid)); __syncthreads(); LAS float* scr = (LAS float*)(lds + RING_OFF + wave * 16384); \
        CONVERT_WEIGHTS_RANGE(l + 1, it0, it1, zfill, (bx - first_idle) * NWAVES + wave, (G - first_idle) * NWAVES, scr); } } } while (0)
    for (int l = 0; l < DEPTH; ++l) {
        const int pb = 2 + l * PH_PER_LAYER;
        if (IN(pb + 0)) { PH_BEGIN
            for (int i = gt; i < 4 * 32 * 1024; i += NGT) { const int c = i & 1023, ko = (i >> 10) & 31, blk = i >> 15; float f[8];
                const bool dat = blk < 2 ? ko < 12 : (ko >= 12 && ko < 24);
                const float* sp = blk < 2 ? INP(10) + (((size_t)l * 2 + blk) * 96 + ko * 8) * 1024 + c : INP(12) + (((size_t)l * 2 + (blk - 2)) * 96 + (ko - 12) * 8) * 1024 + c;
#pragma unroll
                for (int e = 0; e < 8; ++e) f[e] = dat ? sp[(size_t)e * 1024] : 0.f;
                *(v4u*)(W_(bf16, WS_WL1) + ((size_t)(blk * 1024 + c) * 256 + ko * 8)) = pack8(f); }
            for (int i = gt; i < 32 * 1024; i += NGT) { const int c = i & 1023, ko = i >> 10; float f[8];
#pragma unroll
                for (int e = 0; e < 8; ++e) f[e] = INP(18)[((size_t)l * 256 + ko * 8 + e) * 1024 + c];
                *(v4u*)(W_(bf16, WS_WG) + ((size_t)c * 256 + ko * 8)) = pack8(f); }
            NORM_ROWS(INP(6) + (size_t)l * DM, 0, DM, (l == 0 ? (r < ML ? INP(0) + (size_t)r * DM : INP(2) + (size_t)(r - ML) * DM) : (const float*)nullptr),
                      if (r >= ML && l > 0) ctx_row_add_partials(W_(unsigned short, WS_X) + (size_t)r * DM, nullptr, W_(float, WS_PARTK) + (size_t)(r - ML) * DM, W_(float, WS_MOD) + (size_t)(l - 1) * 3 * MODW + 2 * MODW + 5 * DM, lane));
            __syncthreads();
        }
        ENDPH(pb + 0);
        if (IN(pb + 1)) { PH_BEGIN
            pg8::Gemm g{W_(bf16, WS_XN), W_(bf16, WS_WIN + (size_t)(l & 1) * WS_WSET), MR, DINP, DM, DM, DM}; pg8::StaticOrder S; S.init(MR, DINP, G, bx);
            pg8::EpiStoreBf16 E{W_(bf16, WS_PX), DINP, 0, 0, 1.0f};
            pg8::gemm_phase<pg8::EpiStoreBf16, pg8::StaticOrder, true, true>(lds + RING_OFF, g, S, E, tid);
            TAIL_CONVERT(S.nwg, 0, CVT_Q1, true);
        }
        ENDPH(pb + 1);
        if (IN(pb + 2)) { PH_BEGIN
            const float* sh = INP(8) + (size_t)l * 3 * RWC; const float* cw = INP(19) + (size_t)l * 3 * DC;
            { const int cv = gt & 63, dcol = cv * 8; const int zero = (cv >= 24 && cv < 32); const int sc = WD0 + (cv < 24 ? dcol : dcol - 64);
              float c0[8], c1[8], c2[8];
#pragma unroll
              for (int j = 0; j < 8; ++j) { c0[j] = zero ? 0.f : sh[sc + j]; c1[j] = zero ? 0.f : sh[RWC + sc + j]; c2[j] = zero ? 0.f : sh[2 * RWC + sc + j]; }
              constexpr int RB = 3;
              const int nx_ = 272 > G ? (272 - G < G ? 272 - G : 0) : 0;
              const int rw0 = (gt >> 6) - nx_ * NWAVES, rws = (NGT >> 6) - nx_ * NWAVES;
              for (int r0 = bx >= nx_ ? rw0 : MR; r0 < MR; r0 += RB * rws) {
                  v4u wc_[RB], wp_[RB], wn_[RB];
#pragma unroll
                  for (int i = 0; i < RB; ++i) { const int rr = r0 + i * rws, r = rr < MR ? rr : MR - 1; int t, len; row_seg(r, t, len);
                      const bf16* p = W_(bf16, WS_PX) + (size_t)r * DINP + sc; wc_[i] = (v4u){0u, 0u, 0u, 0u}; wp_[i] = wc_[i]; wn_[i] = wc_[i];
                      if (!zero) { wc_[i] = *(const v4u*)p; if (t > 0) wp_[i] = *(const v4u*)(p - DINP); if (t < len - 1) wn_[i] = *(const v4u*)(p + DINP); } }
#pragma unroll
                  for (int i = 0; i < RB; ++i) { const int r = r0 + i * rws;
                      if (r < MR) { float o[8], cur[8], prv[8], nxt[8]; unpack8(wc_[i], cur); unpack8(wp_[i], prv); unpack8(wn_[i], nxt);
#pragma unroll
                          for (int j = 0; j < 8; ++j) { const float s = c0[j] * prv[j] + c1[j] * cur[j] + c2[j] * nxt[j]; o[j] = zero ? 0.f : (cv < 12 ? tanh_(s) : (cv < 24 ? s : sigm(s))); }
                          *(v4u*)(W_(bf16, WS_LA) + (size_t)r * 512 + dcol) = pack8(o); } } } }
            { constexpr int SBB = 9216;
              LAS unsigned char* Cm = lds + 8 * SBB; LAS unsigned char* Sm = lds + 9 * SBB;
              __syncthreads();
              for (int i = tid; i < 4096; i += NWAVES * 64) { const int cp = i >> 6, cc = i & 63; const float a = (float)((cp * cc) & 63) * (1.0f / 64.0f);
                  *(LAS unsigned short*)(Cm + cp * 144 + cc * 2) = (unsigned short)f2bf(__builtin_amdgcn_cosf(a)); *(LAS unsigned short*)(Sm + cp * 144 + cc * 2) = (unsigned short)f2bf(__builtin_amdgcn_sinf(a)); }
              const int g = lane >> 4, c = lane & 15, mt = wave & 3, nt0 = 2 * (wave >> 2);
              for (int it = bx; it < 272; it += G) {
                  int b, gI, q = 0, nblk, row0;
                  if (it < 256) { b = it >> 7; gI = (it >> 4) & 7; q = it & 15; nblk = 8; row0 = b * SEQ + q * 512; } else { const int j = it - 256; b = j >> 3; gI = j & 7; nblk = 4; row0 = ML + b * CTX; }
                  __syncthreads();
                  for (int v = tid; v < nblk * 512; v += NWAVES * 64) { const int blk = v >> 9, row = (v >> 3) & 63, cv = v & 7;
                      *(LAS v4u*)(lds + blk * SBB + row * 144 + cv * 16) = *(const v4u*)(W_(bf16, WS_PX) + (size_t)(row0 + blk * 64 + row) * DINP + FT0 + gI * 64 + cv * 8); }
                  __syncthreads();
#pragma unroll
                  for (int q2 = 0; q2 < 2; ++q2) { const int nt = nt0 + q2; const f32x4 z4 = {0.f, 0.f, 0.f, 0.f}; f32x4 aC[8], aS[8];
#pragma unroll
                      for (int blk = 0; blk < 8; ++blk) { aC[blk] = mm(lds + blk * SBB, mt, Cm, nt, g, c, z4); aS[blk] = mm(lds + blk * SBB, mt, Sm, nt, g, c, z4); }
                      const int n_ = gI * 64 + 16 * nt + c;
                      if (it < 256) {
#pragma unroll
                          for (int r = 0; r < 4; ++r) { const int l1 = 16 * mt + 4 * g + r; bf16* dst = W_(bf16, WS_D1) + ((((size_t)(b * 512 + n_) * 64 + l1) * 2) * 128 + 8 * q);
                              v4u wr_, wi_;
                              wr_.x = pk2(aC[0][r], aC[1][r]); wr_.y = pk2(aC[2][r], aC[3][r]); wr_.z = pk2(aC[4][r], aC[5][r]); wr_.w = pk2(aC[6][r], aC[7][r]);
                              wi_.x = pk2(-aS[0][r], -aS[1][r]); wi_.y = pk2(-aS[2][r], -aS[3][r]); wi_.z = pk2(-aS[4][r], -aS[5][r]); wi_.w = pk2(-aS[6][r], -aS[7][r]);
                              *(v4u*)dst = wr_; *(v4u*)(dst + 128) = wi_; }
                      } else {
#pragma unroll
                          for (int blk = 0; blk < 4; ++blk) { bf16* dst = W_(bf16, WS_FTC) + ((size_t)b * 512 + n_) * 512 + 64 * blk + 16 * mt + 4 * g;
                              *(v2u*)dst = pack4(aC[blk]); *(v2u*)(dst + CTX) = pack4(aS[blk]); }
                      }
                  }
              }
              __syncthreads();
            }
        }
        ENDPH(pb + 2);
        if (IN(pb + 3)) { PH_BEGIN
            { pg8::Gemm g{W_(bf16, WS_LA), W_(bf16, WS_WL1), MR, 4096, 256, 512, 256}; pg8::StaticOrder S; S.init(MR, 4096, G, bx);
              pg8::EpiLora1 E{W_(unsigned short, WS_LW), W_(bf16, WS_AA), INP(9) + (size_t)l * 2048, INP(11) + (size_t)l * 2048, DSTR};
              pg8::gemm_phase<pg8::EpiLora1, pg8::StaticOrder, true, true>(lds + RING_OFF, g, S, E, tid); }
            asm volatile("" : "+v"(tid));
            { pg8::Gemm g{W_(bf16, WS_F1), W_(bf16, WS_D1), 256, 65536, 256, 256, 256}; pg8::StaticOrder S; S.init(256, 65536, G, bx);
              pg8::EpiFFT1 E{W_(bf16, WS_D2)};
              pg8::gemm_phase<pg8::EpiFFT1, pg8::StaticOrder, true, true>(lds + RING_OFF, g, S, E, tid); }
            for (int b = 0; b < 2; ++b) {
                asm volatile("" : "+v"(tid));
                pg8::Gemm g{W_(bf16, WS_DFTC), W_(bf16, WS_FTC) + (size_t)b * 512 * 512, CTX, 512, 512, 512, 512}; pg8::StaticOrder S; S.init(CTX, 512, G, (bx + G - 48 - b * 2) % G);
                pg8::EpiStoreBf16 E{W_(bf16, WS_MIX), DM, ML + b * CTX, 1536, 0.0078125f};
                pg8::gemm_phase<pg8::EpiStoreBf16, pg8::StaticOrder, true, true>(lds + RING_OFF, g, S, E, tid); }
        }
        ENDPH(pb + 3);
        if (IN(pb + 4)) { PH_BEGIN
            { const float* sh = INP(8) + (size_t)l * 3 * RWC;
              const int hq = gw & 3, c = hq * 256 + lane * 4, h = c >> 6;
              f32x4 shc[3][3];
#pragma unroll
              for (int q = 0; q < 3; ++q)
#pragma unroll
                  for (int w3 = 0; w3 < 3; ++w3) shc[q][w3] = *(const f32x4*)(sh + w3 * RWC + q * 1024 + c);
              const f32x4 kk4 = *(const f32x4*)(INP(13) + (size_t)l * 1024 + c), ka4 = *(const f32x4*)(INP(14) + (size_t)l * 1024 + c), rk4 = *(const f32x4*)(INP(15) + (size_t)l * 1024 + c);
              constexpr int RB = 2;
              for (int r0 = gw >> 2; r0 < MR; r0 += RB * (NGW >> 2)) {
                v2u wc_[RB][3], wp_[RB][3], wn_[RB][3], aw_[RB][2];
#pragma unroll
                for (int i = 0; i < RB; ++i) { const int rr = r0 + i * (NGW >> 2), r = rr < MR ? rr : MR - 1; int t, len; row_seg(r, t, len);
                    const bf16* p = W_(bf16, WS_PX) + (size_t)r * DINP;
#pragma unroll
                    for (int q = 0; q < 3; ++q) { const int sc = q * 1024 + c;
                        wc_[i][q] = *(const v2u*)(p + sc); wp_[i][q] = (v2u){0u, 0u}; wn_[i][q] = (v2u){0u, 0u};
                        if (t > 0) wp_[i][q] = *(const v2u*)(p - DINP + sc); if (t < len - 1) wn_[i][q] = *(const v2u*)(p + DINP + sc); }
#pragma unroll
                    for (int d = 0; d < 2; ++d) aw_[i][d] = *(const v2u*)(W_(bf16, WS_AA) + d * DSTR + (size_t)r * 1024 + c); }
#pragma unroll
                for (int i = 0; i < RB; ++i) { const int r = r0 + i * (NGW >> 2);
                  if (r < MR) {
                    f32x4 sv[3];
#pragma unroll
                    for (int q = 0; q < 3; ++q) { const v2u wc0 = wc_[i][q], wp = wp_[i][q], wn = wn_[i][q];
                        const f32x4 cu = {bflo(wc0.x), bfhi(wc0.x), bflo(wc0.y), bfhi(wc0.y)}, pr = {bflo(wp.x), bfhi(wp.x), bflo(wp.y), bfhi(wp.y)}, nx = {bflo(wn.x), bfhi(wn.x), bflo(wn.y), bfhi(wn.y)};
                        sv[q] = shc[q][0] * pr + shc[q][1] * cu + shc[q][2] * nx; }
                    const f32x4 rv = sv[0], kv = sv[1], vv = sv[2];
                    f32x4 kk = kv * kk4; float n2 = (kk[0] * kk[0] + kk[1] * kk[1]) + (kk[2] * kk[2] + kk[3] * kk[3]);
                    n2 = sum16(n2, lane); kk = kk * (1.0f / fmaxf(sqrtf(n2), KK_EPS));
                    f32x4 ksum = {0.f, 0.f, 0.f, 0.f};
#pragma unroll
                    for (int d = 0; d < 2; ++d) { const v2u aw = aw_[i][d]; const f32x4 a = {sigm(bflo(aw.x)), sigm(bfhi(aw.x)), sigm(bflo(aw.y)), sigm(bfhi(aw.y))};
                        const f32x4 kd = kv * (1.0f + (a - 1.0f) * ka4), bh = kk * a; ksum += kd;
                        *(v2u*)(W_(bf16, WS_KD) + d * DSTR + (size_t)r * 1024 + c) = (v2u){pk2(kd[0], kd[1]), pk2(kd[2], kd[3])};
                        *(v2u*)(W_(bf16, WS_BH) + d * DSTR + (size_t)r * 1024 + c) = (v2u){pk2(bh[0], bh[1]), pk2(bh[2], bh[3])}; }
                    const f32x4 bq = rv * ksum * rk4; float bo = (bq[0] + bq[1]) + (bq[2] + bq[3]);
                    bo = sum16(bo, lane);
                    if ((lane & 15) == 0) W_(float, WS_BONUS)[(size_t)r * 16 + h] = bo;
                    *(v2u*)(W_(bf16, WS_RS) + (size_t)r * 1024 + c) = (v2u){pk2(rv[0], rv[1]), pk2(rv[2], rv[3])};
                    *(v2u*)(W_(bf16, WS_VS) + (size_t)r * 1024 + c) = (v2u){pk2(vv[0], vv[1]), pk2(vv[2], vv[3])};
                    *(v2u*)(W_(bf16, WS_KK) + (size_t)r * 1024 + c) = (v2u){pk2(kk[0], kk[1]), pk2(kk[2], kk[3])};
                  } }
              } }
        }
        ENDPH(pb + 4);
        if (IN(pb + 5)) { PH_BEGIN
            const int g = lane >> 4, c = lane & 15, mt = wave & 3, nt0 = 2 * (wave >> 2);
            constexpr int SBB = 9216;
#define BUF(i) (lds + (i) * SBB)
#define LBAR() do { asm volatile("s_waitcnt lgkmcnt(0)" ::: "memory"); __builtin_amdgcn_s_barrier(); asm volatile("" ::: "memory"); } while (0)
            constexpr int B_AN = 0, B_BN = 1, B_KN = 2, B_RN = 3, B_VN = 4, B_SPN = 5, B_SPT = 6, B_TP = 7, B_S0N = 8, B_S0T = 9, B_T1 = 10, B_AAK = 11, B_ARB = 12, B_ARK = 13, B_M2T = 14;
            LAS float* gam = (LAS float*)(lds + 15 * SBB);
            const f32x4 z4 = {0.f, 0.f, 0.f, 0.f};
            v4u rs_, kd_, vs_, kk_, bh_, lwh_;
#define S1_ROWBASE(it_, rb_, d_, h_) do { const int inst_ = (it_) / NCH, s_ = (it_) - inst_ * NCH; const int b_ = inst_ >> 5; h_ = (inst_ >> 1) & 15; d_ = inst_ & 1; \
    if (s_ < 4) { const int cc = d_ ? 3 - s_ : s_; rb_ = ML + b_ * CTX + cc * 64; } else { const int cc = d_ ? 127 - (s_ - 4) : (s_ - 4); rb_ = b_ * SEQ + cc * 64; } } while (0)
#define S1_LOAD(it_) do { int rb_, d_, h_; S1_ROWBASE(it_, rb_, d_, h_); const int row = rb_ + (d_ ? 63 - lane : lane); const size_t off = (size_t)row * 1024 + h_ * 64 + wave * 8; \
    rs_ = *(const v4u*)(W_(bf16, WS_RS) + off); kd_ = *(const v4u*)(W_(bf16, WS_KD) + d_ * DSTR + off); vs_ = *(const v4u*)(W_(bf16, WS_VS) + off); \
    kk_ = *(const v4u*)(W_(bf16, WS_KK) + off); bh_ = *(const v4u*)(W_(bf16, WS_BH) + d_ * DSTR + off); \
    lwh_ = *(const v4u*)(W_(unsigned short, WS_LW) + d_ * DSTR + off); } while (0)
            const int per_ = (64 * NCH + G - 1) / G, it_end = (bx + 1) * per_ < 64 * NCH ? (bx + 1) * per_ : 64 * NCH;
            if (bx * per_ < it_end) S1_LOAD(bx * per_);
            for (int it = bx * per_; it < it_end; ++it) {
                { float lwv[8], lam[8]; pg8::unpack_h8(lwh_, lwv);
#pragma unroll
                  for (int e = 0; e < 8; ++e) lam[e] = wave_incl_scan(lwv[e]);
                  if (lane == 63) {
#pragma unroll
                      for (int e = 0; e < 8; ++e) gam[wave * 8 + e] = __expf(lam[e]); }
                  float r_[8], k_[8], q_[8], b_[8], an[8], rn[8], bn[8], kn[8];
                  unpack8(rs_, r_); unpack8(kd_, k_); unpack8(kk_, q_); unpack8(bh_, b_);
#pragma unroll
                  for (int e = 0; e < 8; ++e) { const float eL = __expf(lam[e]), eLx = __expf(lam[e] - lwv[e]), emL = __expf(-lam[e]);
                      an[e] = -q_[e] * eLx; rn[e] = r_[e] * eL; bn[e] = b_[e] * emL; kn[e] = k_[e] * emL; }
                  *(LAS v4u*)(BUF(B_AN) + lane * 144 + wave * 16) = pack8(an); *(LAS v4u*)(BUF(B_RN) + lane * 144 + wave * 16) = pack8(rn);
                  *(LAS v4u*)(BUF(B_BN) + lane * 144 + wave * 16) = pack8(bn); *(LAS v4u*)(BUF(B_KN) + lane * 144 + wave * 16) = pack8(kn);
                  *(LAS v4u*)(BUF(B_VN) + lane * 144 + wave * 16) = vs_;
                }
                if (it + 1 < it_end) S1_LOAD(it + 1);
                LBAR();
                { const bool nzq[2] = {nt0 <= mt, nt0 + 1 <= mt};
                  const pg8::bf16x8 zf = {0, 0, 0, 0, 0, 0, 0, 0}; Fr2 fA, fR, fB[2], fK[2]; fA.k0 = zf; fA.k1 = zf; fR = fA; fB[0] = fA; fB[1] = fA; fK[0] = fA; fK[1] = fA;
                  if (nzq[0]) { fA = ldf2(BUF(B_AN), mt, g, c); fR = ldf2(BUF(B_RN), mt, g, c); }
#pragma unroll
                  for (int q = 0; q < 2; ++q) if (nzq[q]) { fB[q] = ldf2(BUF(B_BN), nt0 + q, g, c); fK[q] = ldf2(BUF(B_KN), nt0 + q, g, c); }
                  f32x4 abn[2], abt[2], akn[2], rbn[2], rkn[2];
#pragma unroll
                  for (int q = 0; q < 2; ++q) { abn[q] = z4; abt[q] = z4; akn[q] = z4; rbn[q] = z4; rkn[q] = z4;
                      if (nzq[q]) { abn[q] = mmf(fB[q], fA, z4); if (nt0 + q == mt) abt[q] = mmf(fA, fB[q], z4); akn[q] = mmf(fK[q], fA, z4); rbn[q] = mmf(fB[q], fR, z4); rkn[q] = mmf(fK[q], fR, z4); } }
#pragma unroll
                  for (int q = 0; q < 2; ++q) { const int nt = nt0 + q;
                    const int mN = 16 * mt + c, nN = 16 * nt + 4 * g;
                    const int mT = 16 * mt + 4 * g, nT = 16 * nt + c;
#pragma unroll
                    for (int r = 0; r < 4; ++r) { const bool st = (nN + r) < mN, inc = (nN + r) <= mN;
                        abn[q][r] = st ? abn[q][r] : 0.f; akn[q][r] = st ? akn[q][r] : 0.f; rbn[q][r] = inc ? rbn[q][r] : 0.f; rkn[q][r] = inc ? rkn[q][r] : 0.f;
                        abt[q][r] = nT < (mT + r) ? abt[q][r] : 0.f; }
                    st_nat(BUF(B_S0N), mt, nt, g, c, abn[q]); if (nt == mt) st_tr(BUF(B_S0T), mt, nt, g, c, abt[q]);
                    st_nat(BUF(B_AAK), mt, nt, g, c, akn[q]); st_nat(BUF(B_ARB), mt, nt, g, c, rbn[q]); st_nat(BUF(B_ARK), mt, nt, g, c, rkn[q]);
                    st_nat(BUF(B_SPN), mt, nt, g, c, z4); if (nt != mt) st_nat(BUF(B_TP), mt, nt, g, c, z4); } }
                LBAR();
                Fr2 fVt[2];
                { const Fr2 fAK = ldf2(BUF(B_AAK), mt, g, c); f32x4 m2[2];
#pragma unroll
                  for (int q = 0; q < 2; ++q) fVt[q] = ldf2_tr(BUF(B_VN), nt0 + q, g, c);
#pragma unroll
                  for (int q = 0; q < 2; ++q) m2[q] = mmf(fAK, fVt[q], z4);
#pragma unroll
                  for (int q = 0; q < 2; ++q) st_tr(BUF(B_M2T), mt, nt0 + q, g, c, m2[q]);
                  if (nt0 == 2 * (mt >> 1)) {
                      const int to = (16 * mt + c) * 144 + (16 * mt + 4 * g) * 2;
                      const v2u wN = *(LAS const v2u*)(BUF(B_S0N) + to), wT = *(LAS const v2u*)(BUF(B_S0T) + to);
#define S1_FR(w_) __builtin_bit_cast(pg8::bf16x8, ((pg8::u32x4){(w_).x, (w_).y, 0u, 0u}))
                      f32x4 tn = {bflo(wN.x), bfhi(wN.x), bflo(wN.y), bfhi(wN.y)};
#pragma unroll
                      for (int r = 0; r < 4; ++r) tn[r] += (4 * g + r) == c ? 1.f : 0.f;
                      const v2u wI = pack4(tn);
                      pg8::bf16x8 fSN = S1_FR(wN), fST = S1_FR(wT), fTN = S1_FR(wI);
#pragma unroll
                      for (int rr = 1; rr <= 4; ++rr) {
                          if (rr >= 2) tn = __builtin_amdgcn_mfma_f32_16x16x32_bf16(fST, fTN, tn, 0, 0, 0);
                          if (rr <= 3) { const f32x4 zn = __builtin_amdgcn_mfma_f32_16x16x32_bf16(fST, fSN, z4, 0, 0, 0), zt = __builtin_amdgcn_mfma_f32_16x16x32_bf16(fSN, fST, z4, 0, 0, 0);
                              const v2u pn = pack4(zn), pt = pack4(zt); fSN = S1_FR(pn); fST = S1_FR(pt); }
                          if (rr >= 2 && rr <= 3) { const v2u pq = pack4(tn); fTN = S1_FR(pq); }
                      }
#undef S1_FR
                      st_nat(BUF(B_TP), mt, mt, g, c, tn); } }
                LBAR();
                if (wave < 2) {
                    const int mb = wave ? 3 : 1, nb = wave ? 2 : 0, ks = wave;
                    const f32x4 u = __builtin_amdgcn_mfma_f32_16x16x32_bf16(ldf_tr(BUF(B_TP), nb, ks, g, c), ldf(BUF(B_S0N), mb, ks, g, c), z4, 0, 0, 0);
                    st_nat(BUF(B_SPN), mb, nb, g, c, u);
                    asm volatile("s_waitcnt lgkmcnt(0)" ::: "memory");
                    const f32x4 v = __builtin_amdgcn_mfma_f32_16x16x32_bf16(ldf_tr(BUF(B_SPN), nb, ks, g, c), ldf(BUF(B_TP), mb, ks, g, c), z4, 0, 0, 0);
                    st_nat(BUF(B_TP), mb, nb, g, c, v); }
                LBAR();
                if (wave < 4) {
                    const int mb = 2 + (wave >> 1), nb = wave & 1;
                    const f32x4 y = __builtin_amdgcn_mfma_f32_16x16x32_bf16(ldf_tr(BUF(B_TP), nb, 0, g, c), ldf(BUF(B_S0N), mb, 0, g, c), z4, 0, 0, 0);
                    st_nat(BUF(B_SPN), mb, nb, g, c, y); }
                LBAR();
                if (wave < 4) {
                    const int mb = 2 + (wave >> 1), nb = wave & 1;
                    const f32x4 x = __builtin_amdgcn_mfma_f32_16x16x32_bf16(ldf_tr(BUF(B_SPN), nb, 1, g, c), ldf(BUF(B_TP), mb, 1, g, c), z4, 0, 0, 0);
                    st_nat(BUF(B_TP), mb, nb, g, c, x); }
                LBAR();
                { const bool hi = mt >= 2;
                  const pg8::bf16x8 fT0 = ldf(BUF(B_TP), mt, 0, g, c); f32x4 w1[2], ul[2];
#pragma unroll
                  for (int q = 0; q < 2; ++q) { w1[q] = __builtin_amdgcn_mfma_f32_16x16x32_bf16(fT0, ldf_tr(BUF(B_AN), nt0 + q, 0, g, c), z4, 0, 0, 0); ul[q] = __builtin_amdgcn_mfma_f32_16x16x32_bf16(fT0, ldf(BUF(B_M2T), nt0 + q, 0, g, c), z4, 0, 0, 0); }
                  if (hi) { const pg8::bf16x8 fT1 = ldf(BUF(B_TP), mt, 1, g, c);
#pragma unroll
                      for (int q = 0; q < 2; ++q) { w1[q] = __builtin_amdgcn_mfma_f32_16x16x32_bf16(fT1, ldf_tr(BUF(B_AN), nt0 + q, 1, g, c), w1[q], 0, 0, 0); ul[q] = __builtin_amdgcn_mfma_f32_16x16x32_bf16(fT1, ldf(BUF(B_M2T), nt0 + q, 1, g, c), ul[q], 0, 0, 0); } }
#pragma unroll
                  for (int q = 0; q < 2; ++q) { st_tr(BUF(B_S0N), mt, nt0 + q, g, c, w1[q]); st_tr(BUF(B_T1), mt, nt0 + q, g, c, ul[q]); } }
                LBAR();
                { const int ix_ = (it % NCH) * 64 + it / NCH;
                  unsigned char* ib = ix_ < SCR1_ITEMS ? W_(unsigned char, WS_SCR1) + (size_t)ix_ * ITEM_BYTES : W_(unsigned char, WS_SCR3) + (size_t)(ix_ - SCR1_ITEMS) * ITEM_BYTES;
                  const bool hi = mt >= 2;
                  Fr2 fARB, fARK; fARB.k0 = ldf(BUF(B_ARB), mt, 0, g, c); fARK.k0 = ldf(BUF(B_ARK), mt, 0, g, c); fARB.k1 = fARB.k0; fARK.k1 = fARK.k0;
                  if (hi) { fARB.k1 = ldf(BUF(B_ARB), mt, 1, g, c); fARK.k1 = ldf(BUF(B_ARK), mt, 1, g, c); }
                  const Fr2 fBT = ldf2_tr(BUF(B_BN), mt, g, c), fKT = ldf2_tr(BUF(B_KN), mt, g, c);
                  const float gj = gam[16 * mt + c]; const f32x4 g4 = *(LAS const f32x4*)(gam + 16 * mt + 4 * g);
#pragma unroll
                  for (int q = 0; q < 2; ++q) { const int nt = nt0 + q;
                      const Fr2 fUL = ldf2(BUF(B_T1), nt, g, c), fW1 = ldf2(BUF(B_S0N), nt, g, c);
                      const v2u rw = *(LAS const v2u*)(BUF(B_RN) + (16 * mt + c) * 144 + (16 * nt + 4 * g) * 2); const f32x4 r0 = {bflo(rw.x), bfhi(rw.x), bflo(rw.y), bfhi(rw.y)};
                      f32x4 yl = __builtin_amdgcn_mfma_f32_16x16x32_bf16(fUL.k0, fARB.k0, z4, 0, 0, 0); yl = __builtin_amdgcn_mfma_f32_16x16x32_bf16(fVt[q].k0, fARK.k0, yl, 0, 0, 0);
                      f32x4 rh = __builtin_amdgcn_mfma_f32_16x16x32_bf16(fW1.k0, fARB.k0, r0, 0, 0, 0);
                      if (hi) { yl = __builtin_amdgcn_mfma_f32_16x16x32_bf16(fUL.k1, fARB.k1, yl, 0, 0, 0); yl = __builtin_amdgcn_mfma_f32_16x16x32_bf16(fVt[q].k1, fARK.k1, yl, 0, 0, 0); rh = __builtin_amdgcn_mfma_f32_16x16x32_bf16(fW1.k1, fARB.k1, rh, 0, 0, 0); }
                      f32x4 pt = mmf(fW1, fBT, z4);
                      f32x4 qq = mmf(fBT, fUL, z4); qq = mmf(fKT, fVt[q], qq);
                      unsigned char* opP = ib + ((2 * mt + (nt >> 1)) * 64 + lane) * 16 + (nt & 1) * 8;
                      unsigned char* opQ = ib + ((2 * nt + (mt >> 1)) * 64 + lane) * 16 + (mt & 1) * 8;
                      *(v2u*)(opQ + 24576) = pack4(yl); *(v2u*)(opP + 8192) = pack4(rh);
#pragma unroll
                      for (int r = 0; r < 4; ++r) pt[r] = gj * (pt[r] + ((16 * nt + 4 * g + r) == (16 * mt + c) ? 1.f : 0.f));
                      *(v2u*)opP = pack4(pt); *(v2u*)(opQ + 16384) = pack4(qq * g4); }
                }
                LBAR();
            }
#undef BUF
#undef LBAR
#undef S1_LOAD
#undef S1_ROWBASE
        }
        if (IN(pb + 5) && IN(pb + 6)) { if (G0 == 64 * NSEG) { asm volatile("s_waitcnt vmcnt(0)" ::: "memory"); __syncthreads(); } else GRID_BAR(); }
        if (IN(pb + 6)) { PH_BEGIN
            const int g = lane >> 4, c = lane & 15;
#define S2_ITEM(s_, inst_) (((s_) * 64 + (inst_)) < SCR1_ITEMS ? W_(unsigned char, WS_SCR1) + (size_t)((s_) * 64 + (inst_)) * ITEM_BYTES : W_(unsigned char, WS_SCR3) + (size_t)((s_) * 64 + (inst_) - SCR1_ITEMS) * ITEM_BYTES)
#define S2_COMPOSITE(inst_, j_) (W_(unsigned char, WS_COMP) + (size_t)((inst_) * (NSEG - 1) + (j_)) * ITEM_BYTES)
#define S2_UNP(w_) (f32x4){bflo((w_).x), bfhi((w_).x), bflo((w_).y), bfhi((w_).y)}
#define S2_UNP2(w_) (f32x4){bflo((w_).z), bfhi((w_).z), bflo((w_).w), bfhi((w_).w)}
#define S2_PACKH(a_, b_) ({ pg8::u32x4 w_; w_.x = pg8::cvt_pk_bf16((a_)[0], (a_)[1]); w_.y = pg8::cvt_pk_bf16((a_)[2], (a_)[3]); w_.z = pg8::cvt_pk_bf16((b_)[0], (b_)[1]); w_.w = pg8::cvt_pk_bf16((b_)[2], (b_)[3]); __builtin_bit_cast(pg8::bf16x8, w_); })
            for (int u = bx; u < 64 * NSEG; u += G) {
                const int inst = G == 64 * NSEG ? u >> 2 : u & 63, seg = G == 64 * NSEG ? u & 3 : u >> 6;
                if (seg == NSEG - 1) continue;
                const int lw = wave & 3;
                unsigned goff[4];
#pragma unroll
                for (int j = 0; j < 4; ++j) goff[j] = (unsigned)((j < 2 ? 2 * lw + j : 14 + 2 * lw + j) * 1024 + lane * 16);
#define S2A_ISSUE(slot, t_) do { if (wave >= 4) { const unsigned char* ib = S2_ITEM(seg * SEGLEN + (t_), inst); \
    _Pragma("unroll") for (int j = 0; j < 4; ++j) __builtin_amdgcn_global_load_lds((const unsigned*)(ib + goff[j]), (LAS unsigned*)(lds + (slot) * 32768 + (j < 2 ? 2 * lw + j : 14 + 2 * lw + j) * 1024), 16, 0, 0); } } while (0)
#define S2A_WAIT(t_) do { if (wave >= 4) { if ((t_) >= SEGLEN - 3) asm volatile("s_waitcnt vmcnt(0)" ::: "memory"); else asm volatile("s_waitcnt vmcnt(8)" ::: "memory"); } \
    __builtin_amdgcn_s_barrier(); asm volatile("" ::: "memory"); } while (0)
                pg8::bf16x8 Hq0 = {0, 0, 0, 0, 0, 0, 0, 0}, Hq1 = Hq0, Hp0, Hp1;
                { unsigned p0[4] = {0u, 0u, 0u, 0u}, p1[4] = {0u, 0u, 0u, 0u}; const int jt = 16 * wave + c;
#pragma unroll
                  for (int e = 0; e < 8; ++e) { const int j = 16 * (e >> 2) + 4 * g + (e & 3); const unsigned one = 0x3F80u << (16 * (e & 1));
                      if (j == jt) p0[e >> 1] |= one; if (j + 32 == jt) p1[e >> 1] |= one; }
                  Hp0 = __builtin_bit_cast(pg8::bf16x8, ((pg8::u32x4){p0[0], p0[1], p0[2], p0[3]})); Hp1 = __builtin_bit_cast(pg8::bf16x8, ((pg8::u32x4){p1[0], p1[1], p1[2], p1[3]})); }
                __syncthreads();
                S2A_ISSUE(0, 0); S2A_ISSUE(1, 1); S2A_ISSUE(2, 2);
                for (int t = 0; t < SEGLEN; ++t) {
                    S2A_WAIT(t);
                    if (t + 3 < SEGLEN) S2A_ISSUE((t + 3) & 3, t + 3);
                    if (wave < 4) {
                        LAS const unsigned char* sl_ = lds + (t & 3) * 32768 + lane * 16;
                        const v4u q0 = *(LAS const v4u*)(sl_ + (16 + 2 * wave) * 1024), q1 = *(LAS const v4u*)(sl_ + (17 + 2 * wave) * 1024);
                        pg8::bf16x8 pf_[4][2];
#pragma unroll
                        for (int k = 0; k < 8; ++k) pf_[k >> 1][k & 1] = *(LAS const pg8::bf16x8*)(sl_ + k * 1024);
                        const f32x4 z4 = {0.f, 0.f, 0.f, 0.f};
                        f32x4 aq[4] = {S2_UNP(q0), S2_UNP2(q0), S2_UNP(q1), S2_UNP2(q1)}, ap[4] = {z4, z4, z4, z4};
#pragma unroll
                        for (int jb = 0; jb < 4; ++jb) {
                            aq[jb] = __builtin_amdgcn_mfma_f32_16x16x32_bf16(pf_[jb][0], Hq0, aq[jb], 0, 0, 0); ap[jb] = __builtin_amdgcn_mfma_f32_16x16x32_bf16(pf_[jb][0], Hp0, ap[jb], 0, 0, 0);
                            aq[jb] = __builtin_amdgcn_mfma_f32_16x16x32_bf16(pf_[jb][1], Hq1, aq[jb], 0, 0, 0); ap[jb] = __builtin_amdgcn_mfma_f32_16x16x32_bf16(pf_[jb][1], Hp1, ap[jb], 0, 0, 0); }
                        Hq0 = S2_PACKH(aq[0], aq[1]); Hq1 = S2_PACKH(aq[2], aq[3]); Hp0 = S2_PACKH(ap[0], ap[1]); Hp1 = S2_PACKH(ap[2], ap[3]);
                    }
                }
                asm volatile("s_waitcnt vmcnt(0)" ::: "memory");
                __syncthreads();
                unsigned char* cb = S2_COMPOSITE(inst, seg);
                if (wave < 4) {
                    *(v4u*)(cb + (16 + 2 * wave) * 1024 + lane * 16) = __builtin_bit_cast(v4u, Hq0); *(v4u*)(cb + (17 + 2 * wave) * 1024 + lane * 16) = __builtin_bit_cast(v4u, Hq1);
                    const v4u w0 = __builtin_bit_cast(v4u, Hp0), w1 = __builtin_bit_cast(v4u, Hp1);
                    const unsigned ww[8] = {w0.x, w0.y, w0.z, w0.w, w1.x, w1.y, w1.z, w1.w};
#pragma unroll
                    for (int jb = 0; jb < 4; ++jb)
#pragma unroll
                        for (int r = 0; r < 4; ++r) { const unsigned wd_ = ww[jb * 2 + (r >> 1)]; const unsigned short hv = (unsigned short)((r & 1) ? (wd_ >> 16) : (wd_ & 0xffffu));
                            *(LAS unsigned short*)(lds + (16 * jb + 4 * g + r) * 144 + (16 * wave + c) * 2) = hv; }
                }
                __syncthreads();
                { const int rowblk = wave >> 1, ks = wave & 1;
                  LAS const unsigned char* rp = lds + (16 * rowblk + c) * 144 + (32 * ks + 4 * g) * 2;
                  const v2u lo_ = *(LAS const v2u*)rp, hi_ = *(LAS const v2u*)(rp + 32);
                  *(v4u*)(cb + wave * 1024 + lane * 16) = (v4u){lo_.x, lo_.y, hi_.x, hi_.y}; }
                asm volatile("s_waitcnt vmcnt(0)" ::: "memory");
                __syncthreads();
                if (tid == 0) { __builtin_amdgcn_fence(__ATOMIC_RELEASE, "agent"); (void)xb_add(W_(unsigned, WS_CTL + SCAN_FLAG_OFF) + l * 256 + u, 1u); }
#undef S2A_ISSUE
#undef S2A_WAIT
            }
            __syncthreads();
            { pg8::Gemm g{W_(bf16, WS_D2), W_(bf16, WS_F2), 131072, 256, 128, 128, 128}; pg8::StaticOrder S; S.init(131072, 256, G, bx);
              pg8::EpiFFT2 E{W_(bf16, WS_MIX), 0.001381067932004975f};
              pg8::gemm_phase<pg8::EpiFFT2, pg8::StaticOrder, true, true>(lds + RING_OFF, g, S, E, tid); }
            asm volatile("" : "+v"(tid));
            { pg8::Gemm g{W_(bf16, WS_LA) + 256, W_(bf16, WS_WG), MR, 1024, 256, 512, 256}; pg8::StaticOrder S; S.init(MR, 1024, G, bx);
              pg8::EpiStoreBf16 E{W_(bf16, WS_G), 1024, 0, 0, 1.0f};
              pg8::gemm_phase<pg8::EpiStoreBf16, pg8::StaticOrder, true, true>(lds + RING_OFF, g, S, E, tid); }
            asm volatile("" : "+v"(tid));
            { const float* cw = INP(19) + (size_t)l * 3 * DC; const int c8 = (gt & 63) * 8; float w0[8], w1[8], w2[8];
#pragma unroll
              for (int j = 0; j < 8; ++j) { w0[j] = cw[c8 + j]; w1[j] = cw[DC + c8 + j]; w2[j] = cw[2 * DC + c8 + j]; }
              constexpr int RB = 2;
              for (int r0 = gt >> 6; r0 < MR; r0 += RB * (NGT >> 6)) {
                  v4u wg_[RB][3], wx_[RB][3], wb_[RB];
#pragma unroll
                  for (int i = 0; i < RB; ++i) { const int rr = r0 + i * (NGT >> 6), r = rr < MR ? rr : MR - 1; int t, len; row_seg(r, t, len);
                      const bool vp = r < ML ? (t & 63) > 0 : t > 0, vn = r < ML ? (t & 63) < 63 : t < len - 1;
                      const bf16* p = W_(bf16, WS_PX) + (size_t)r * DINP; const v4u z_ = {0u, 0u, 0u, 0u};
                      wg_[i][1] = *(const v4u*)(p + CG0 + c8); wx_[i][1] = *(const v4u*)(p + CX0 + c8); wb_[i] = *(const v4u*)(p + CB0 + c8);
                      wg_[i][0] = z_; wx_[i][0] = z_; wg_[i][2] = z_; wx_[i][2] = z_;
                      if (vp) { wg_[i][0] = *(const v4u*)(p - DINP + CG0 + c8); wx_[i][0] = *(const v4u*)(p - DINP + CX0 + c8); }
                      if (vn) { wg_[i][2] = *(const v4u*)(p + DINP + CG0 + c8); wx_[i][2] = *(const v4u*)(p + DINP + CX0 + c8); } }
#pragma unroll
                  for (int i = 0; i < RB; ++i) { const int r = r0 + i * (NGT >> 6);
                      if (r < MR) { float g0[8], x0[8], b0[8], gp[8], xp[8], gn[8], xn[8], o[8];
                          unpack8(wg_[i][1], g0); unpack8(wx_[i][1], x0); unpack8(wb_[i], b0); unpack8(wg_[i][0], gp); unpack8(wx_[i][0], xp); unpack8(wg_[i][2], gn); unpack8(wx_[i][2], xn);
#pragma unroll
                          for (int j = 0; j < 8; ++j) o[j] = b0[j] * (w0[j] * (gp[j] * xp[j]) + w1[j] * (g0[j] * x0[j]) + w2[j] * (gn[j] * xn[j]));
                          *(v4u*)(W_(bf16, WS_MIX) + (size_t)r * DM + 1024 + c8) = pack8(o); } } } }
        }
        if (IN(pb + 6) && IN(pb + 7)) { if (G0 == 64 * NSEG) { asm volatile("s_waitcnt vmcnt(0)" ::: "memory"); __syncthreads();
                if (tid0 == 0) { unsigned* fl = (unsigned*)(ws + WS_CTL + SCAN_FLAG_OFF) + l * 256 + (bx0 & ~3); unsigned* bar_ = (unsigned*)(ws + WS_CTL) + CW_BAR;
                    for (int j = 0; j < (bx0 & 3); ++j) XB_SPIN(xb_ld(&fl[j]) == 0u, bar_);
                    __builtin_amdgcn_fence(__ATOMIC_ACQUIRE, "agent"); }
                __syncthreads(); } else GRID_BAR(); }
        if (IN(pb + 7)) { PH_BEGIN
            const int g = lane >> 4, c = lane & 15;
            for (int u = bx; u < 64 * NSEG; u += G) {
                const int inst = G == 64 * NSEG ? u >> 2 : u & 63, seg = G == 64 * NSEG ? u & 3 : u >> 6, T = SEGLEN + seg;
                const int b = inst >> 5, h = (inst >> 1) & 15, d = inst & 1;
                bf16* Y = (d ? W_(bf16, WS_YB) : W_(bf16, WS_YF)) + h * 64 + 16 * (wave & 3) + 4 * g;
                pg8::bf16x8 Hf0 = {0, 0, 0, 0, 0, 0, 0, 0}, Hf1 = Hf0;
                unsigned goff[8];
#pragma unroll
                for (int j = 0; j < 8; ++j) goff[j] = (unsigned)((8 * (wave & 3) + j) * 1024 + lane * 16);
#define S2_ISSUE(slot, t_) do { if (wave >= 4) { const unsigned char* ib = (t_) < seg ? S2_COMPOSITE(inst, (t_)) : S2_ITEM(seg * SEGLEN + (t_) - seg, inst); \
    _Pragma("unroll") for (int j = 0; j < 8; ++j) __builtin_amdgcn_global_load_lds((const unsigned*)(ib + goff[j]), (LAS unsigned*)(lds + (slot) * 32768 + (8 * (wave & 3) + j) * 1024), 16, 0, 2);        } } while (0)
#define S2_WAIT(t_) do { if (wave >= 4) { if ((t_) >= T - 3) asm volatile("s_waitcnt vmcnt(0)" ::: "memory"); else asm volatile("s_waitcnt vmcnt(16)" ::: "memory"); } \
    __builtin_amdgcn_s_barrier(); asm volatile("" ::: "memory"); } while (0)
                __syncthreads();
                S2_ISSUE(0, 0); S2_ISSUE(1, 1); S2_ISSUE(2, 2);
                for (int t = 0; t < T; ++t) {
                    S2_WAIT(t);
                    if (t + 3 < T) S2_ISSUE((t + 3) & 3, t + 3);
                    if (wave < 4) {
                        LAS const unsigned char* sl_ = lds + (t & 3) * 32768 + lane * 16;
                        const v4u q0 = *(LAS const v4u*)(sl_ + (16 + 2 * wave) * 1024), q1 = *(LAS const v4u*)(sl_ + (17 + 2 * wave) * 1024);
                        pg8::bf16x8 pf_[4][2];
#pragma unroll
                        for (int k = 0; k < 8; ++k) pf_[k >> 1][k & 1] = *(LAS const pg8::bf16x8*)(sl_ + k * 1024);
                        f32x4 ah_[4] = {S2_UNP(q0), S2_UNP2(q0), S2_UNP(q1), S2_UNP2(q1)};
                        if (t >= seg) {
                            const int s = seg * SEGLEN + t - seg; int rowbase;
                            if (s < 4) { const int cc = d ? 3 - s : s; rowbase = ML + b * CTX + cc * 64; } else { const int cc = d ? 127 - (s - 4) : (s - 4); rowbase = b * SEQ + cc * 64; }
                            const v4u y0 = *(LAS const v4u*)(sl_ + (24 + 2 * wave) * 1024), y1 = *(LAS const v4u*)(sl_ + (25 + 2 * wave) * 1024);
                            pg8::bf16x8 rf_[4][2];
#pragma unroll
                            for (int k = 0; k < 8; ++k) rf_[k >> 1][k & 1] = *(LAS const pg8::bf16x8*)(sl_ + (8 + k) * 1024);
                            f32x4 ay_[4] = {S2_UNP(y0), S2_UNP2(y0), S2_UNP(y1), S2_UNP2(y1)};
#pragma unroll
                            for (int tb = 0; tb < 4; ++tb) { ay_[tb] = __builtin_amdgcn_mfma_f32_16x16x32_bf16(Hf0, rf_[tb][0], ay_[tb], 0, 0, 0); ay_[tb] = __builtin_amdgcn_mfma_f32_16x16x32_bf16(Hf1, rf_[tb][1], ay_[tb], 0, 0, 0);
                                const int tau = 16 * tb + c; *(v2u*)(Y + (size_t)(rowbase + (d ? 63 - tau : tau)) * 1024) = pack4(ay_[tb]); }
                        }
#pragma unroll
                        for (int jb = 0; jb < 4; ++jb) { ah_[jb] = __builtin_amdgcn_mfma_f32_16x16x32_bf16(pf_[jb][0], Hf0, ah_[jb], 0, 0, 0); ah_[jb] = __builtin_amdgcn_mfma_f32_16x16x32_bf16(pf_[jb][1], Hf1, ah_[jb], 0, 0, 0); }
                        Hf0 = S2_PACKH(ah_[0], ah_[1]); Hf1 = S2_PACKH(ah_[2], ah_[3]);
                    }
                }
                asm volatile("s_waitcnt vmcnt(0)" ::: "memory");
                __syncthreads();
#undef S2_ISSUE
#undef S2_WAIT
            }
#undef S2_ITEM
#undef S2_COMPOSITE
#undef S2_UNP
#undef S2_UNP2
#undef S2_PACKH
        }
        ENDPH(pb + 7);
        if (IN(pb + 8)) { PH_BEGIN
            { const int hq = gw & 3, c = hq * 256 + lane * 4, h = c >> 6;
              const f32x4 lnw4 = *(const f32x4*)(INP(16) + (size_t)l * 1024 + c), lnb4 = *(const f32x4*)(INP(17) + (size_t)l * 1024 + c);
              constexpr int RB = 4;
              for (int r0 = gw >> 2; r0 < MR; r0 += RB * (NGW >> 2)) {
                v2u yfw[RB], ybw[RB], vw[RB], gw_[RB]; float bo[RB];
#pragma unroll
                for (int i = 0; i < RB; ++i) { const int rr = r0 + i * (NGW >> 2), r = rr < MR ? rr : MR - 1;
                    yfw[i] = *(const v2u*)(W_(bf16, WS_YF) + (size_t)r * 1024 + c); ybw[i] = *(const v2u*)(W_(bf16, WS_YB) + (size_t)r * 1024 + c);
                    bo[i] = W_(float, WS_BONUS)[(size_t)r * 16 + h];
                    vw[i] = *(const v2u*)(W_(bf16, WS_VS) + (size_t)r * 1024 + c); gw_[i] = *(const v2u*)(W_(bf16, WS_G) + (size_t)r * 1024 + c); }
#pragma unroll
                for (int i = 0; i < RB; ++i) { const int r = r0 + i * (NGW >> 2);
                    const f32x4 yf = {bflo(yfw[i].x), bfhi(yfw[i].x), bflo(yfw[i].y), bfhi(yfw[i].y)}, yb = {bflo(ybw[i].x), bfhi(ybw[i].x), bflo(ybw[i].y), bfhi(ybw[i].y)};
                    const f32x4 y = yf + yb;
                    const float mu = sum16((y.x + y.y) + (y.z + y.w), lane) * (1.0f / 64.0f);
                    const f32x4 dv = y - mu;
                    const float var = sum16((dv.x * dv.x + dv.y * dv.y) + (dv.z * dv.z + dv.w * dv.w), lane) * (1.0f / 64.0f);
                    const float rstd = 1.0f / sqrtf(var + GN_EPS);
                    const f32x4 vv = {bflo(vw[i].x), bfhi(vw[i].x), bflo(vw[i].y), bfhi(vw[i].y)}, gv = {bflo(gw_[i].x), bfhi(gw_[i].x), bflo(gw_[i].y), bfhi(gw_[i].y)};
                    const f32x4 o = (dv * rstd * lnw4 + lnb4 + vv * bo[i]) * gv;
                    if (r < MR) *(v2u*)(W_(bf16, WS_MIX) + (size_t)r * DM + c) = (v2u){pk2(o[0], o[1]), pk2(o[2], o[3])}; }
              } }
        }
        ENDPH(pb + 8);
        if (IN(pb + 9)) { PH_BEGIN
            pg8::Gemm g{W_(bf16, WS_MIX), W_(bf16, WS_WOUT + (size_t)(l & 1) * WS_WSET), MR, DM, DM, DM, DM}; pg8::SplitOrder S; S.init(ML, l + 1 < DEPTH ? 2 : 0, DM, DM / 64, 4, G, bx);
            pg8::EpiResGate E{W_(unsigned short, WS_X), MODL + 2 * DM, W_(float, WS_PARTH), l == 0 ? INP(0) : (const float*)nullptr};
            pg8::gemm_phase<pg8::EpiResGate, pg8::SplitOrder, true, true>(lds + RING_OFF, g, S, E, tid);
        }
        ENDPH(pb + 9);
        if (IN(pb + 10)) { PH_BEGIN
            NORM_ROWS(INP(21) + (size_t)l * DM, 3 * DM, 4 * DM, (const float*)nullptr,
                      if (r >= ML) ctx_row_add_partials(W_(unsigned short, WS_X) + (size_t)r * DM, l == 0 ? INP(2) + (size_t)(r - ML) * DM : (const float*)nullptr, W_(float, WS_PARTH) + (size_t)(r - ML) * DM, MODL + 2 * MODW + 2 * DM, lane));
        }
        ENDPH(pb + 10);
        if (IN(pb + 11)) { PH_BEGIN
            const int mj = l + 1 < DEPTH ? MR : ML;
            pg8::Gemm g{W_(bf16, WS_XN), W_(bf16, WS_WGU + (size_t)(l & 1) * WS_WSET), mj, 2 * DFF, DM, DM, DM}; pg8::StaticOrder S; S.init(mj, 2 * DFF, G, bx);
            pg8::EpiSwiGLU E{W_(bf16, WS_H), DFF};
            pg8::gemm_phase<pg8::EpiSwiGLU, pg8::StaticOrder, true, true>(lds + RING_OFF, g, S, E, tid);
            TAIL_CONVERT(S.nwg, CVT_Q1, CVT_Q2, false);
        }
        ENDPH(pb + 11);
        if (IN(pb + 12)) { PH_BEGIN
            pg8::Gemm g{W_(bf16, WS_H), W_(bf16, WS_WDN + (size_t)(l & 1) * WS_WSET), MR, DM, DFF, DFF, DFF}; pg8::SplitOrder S; S.init(ML, l + 1 < DEPTH ? 2 : 0, DM, DFF / 64, 4, G, bx);
            pg8::EpiResGate E{W_(unsigned short, WS_X), MODL + 5 * DM, W_(float, WS_PARTK), (const float*)nullptr};
            pg8::gemm_phase<pg8::EpiResGate, pg8::SplitOrder, true, true>(lds + RING_OFF, g, S, E, tid);
            TAIL_CONVERT(S.nlat + S.nsub, CVT_Q2, CVT_NIT, false);
        }
        ENDPH(pb + 12);
    }
    if (IN(NPHASES - 1)) { PH_BEGIN
        for (int r = gw; r < ML; r += NGW) {
            const unsigned short* xr = W_(unsigned short, WS_X) + (size_t)r * DM; float v[4][8]; float s = 0.f;
#pragma unroll
            for (int jj = 0; jj < 4; ++jj) { pg8::unpack_h8(*(const v4u*)(xr + 8 * (64 * jj + lane)), v[jj]);
#pragma unroll
                for (int e = 0; e < 8; ++e) s += v[jj][e] * v[jj][e]; }
            const float rstd = 1.0f / sqrtf(wave_sum(s, lane) * (1.0f / DM) + RMS_EPS);
            float* o = (float*)(GAS float*)(args.out + (size_t)r * DM);
#pragma unroll
            for (int jj = 0; jj < 4; ++jj) { const int c8 = 8 * (64 * jj + lane); const f32x4 n0 = *(const f32x4*)(INP(25) + c8), n1 = *(const f32x4*)(INP(25) + c8 + 4);
                *(f32x4*)(o + c8) = (f32x4){v[jj][0], v[jj][1], v[jj][2], v[jj][3]} * rstd * n0; *(f32x4*)(o + c8 + 4) = (f32x4){v[jj][4], v[jj][5], v[jj][6], v[jj][7]} * rstd * n1; }
        }
    }
#undef IN
#undef ENDPH
}

extern "C" void kernel_launch(void* const* d_in, const int* in_sizes, int n_in, void* d_out, int out_size, void* d_ws, size_t ws_size, hipStream_t stream) {
    static int grid = 0;
    if (grid == 0) {
        if (n_in != 26 || ws_size < WS_END) { fprintf(stderr, "kernel_launch: bad inputs n_in %d ws %zu (need %zu)\n", n_in, ws_size, (size_t)WS_END); grid = -1; return; }
        int dev = 0, cus = 0, per_cu = 0;
        if (hipGetDevice(&dev) != hipSuccess || hipDeviceGetAttribute(&cus, hipDeviceAttributeMultiprocessorCount, dev) != hipSuccess) { grid = -1; return; }
        if (hipFuncSetAttribute((const void*)skel_fwd, hipFuncAttributeMaxDynamicSharedMemorySize, LDS_BYTES) != hipSuccess) { fprintf(stderr, "kernel_launch: hipFuncSetAttribute failed\n"); grid = -1; return; }
        if (hipOccupancyMaxActiveBlocksPerMultiprocessor(&per_cu, (const void*)skel_fwd, NWAVES * 64, LDS_BYTES) != hipSuccess || per_cu < 1)
            fprintf(stderr, "kernel_launch: occupancy query reports %d\n", per_cu);
        (void)hipGetLastError();
        grid = cus;
    }
    if (grid < 0) return;
    if (hipMemsetAsync((char*)d_ws + WS_CTL, 0, CTL_ZERO_BYTES, stream) != hipSuccess) return;
    Args a{};
    for (int i = 0; i < 26; ++i) a.in[i] = (const float*)d_in[i];
    a.out = (float*)d_out; a.ws = (unsigned char*)d_ws;
#if MK_ONE_LAUNCH
    a.ph_lo = 0; a.ph_hi = NPHASES;
    hipLaunchKernelGGL(skel_fwd, dim3(grid), dim3(NWAVES * 64), LDS_BYTES, stream, a);
#else
    for (int p = 0; p < NPHASES; ++p) { a.ph_lo = p; a.ph_hi = p + 1; hipLaunchKernelGGL(skel_fwd, dim3(grid), dim3(NWAVES * 64), LDS_BYTES, stream, a); }
#endif
}
```

```cpp
#include <hip/hip_runtime.h>
#include <cstdio>
#include <cstdint>

#ifndef MK_ONE_LAUNCH
#define MK_ONE_LAUNCH 1
#endif

namespace pg8 {
#define PG8_LAS __attribute__((address_space(3)))
typedef unsigned short bf16_t;
typedef short bf16x8 __attribute__((ext_vector_type(8)));
typedef float f32x4 __attribute__((ext_vector_type(4)));
typedef unsigned u32x4 __attribute__((ext_vector_type(4)));
typedef unsigned u32x2 __attribute__((ext_vector_type(2)));
constexpr int BM = 256, BK = 64, HALF = 128, HTB = HALF * BK * 2, STAGE_BYTES = 8 * HTB, NXCD = 8, WGM = 8;

__host__ __device__ __forceinline__ int lds_byte(int r, int c) { const int st = (r >> 4) * 2 + (c >> 5), rr = r & 15, cc = c & 31, ob = rr * 64 + cc * 2; return st * 1024 + (ob ^ (((ob >> 9) & 1) << 5)); }
__host__ __device__ __forceinline__ void stage_rc(int b, int& R, int& C) { const int st = b / 1024, sb = b % 1024, swz = sb ^ (((sb >> 9) & 1) << 5); R = (st >> 1) * 16 + swz / 64; C = (st & 1) * 32 + (swz % 64) / 2; }
__host__ __device__ __forceinline__ int perm32(int rho) { const int n = rho >> 4, i = rho & 15; return 8 * (i >> 2) + 4 * n + (i & 3); }

struct Unit { int pm, pn; };
struct Gemm { const bf16_t* A; const bf16_t* Bt; int M, N, K, lda, ldb; };

struct StaticOrder {
    static constexpr bool SPLIT = false;
    int nM, nN, nwg, G, c;
    __host__ __device__ void init(int M, int N, int G_, int c_) { nM = M / BM; nN = N / BM; nwg = nM * nN; G = G_; c = c_; }
    __host__ __device__ __forceinline__ bool next(int i, Unit& u) const {
        const long L = (long)i * G + c; if (L >= nwg) return false;
        int wgid = (int)L; { const int q = nwg / NXCD, r = nwg % NXCD, xcd = wgid % NXCD, off = wgid / NXCD; wgid = (xcd < r ? xcd * (q + 1) : r * (q + 1) + (xcd - r) * q) + off; }
        const int nig = WGM * nN, gid = wgid / nig, fm = gid * WGM, gsz = (nM - fm) < WGM ? (nM - fm) : WGM;
        u.pm = fm + ((wgid % nig) % gsz); u.pn = (wgid % nig) / gsz; return true;
    }
    __device__ __forceinline__ void a_ready(const Unit&) const {}
    __device__ __forceinline__ void done(const Unit&) const {}
};

struct SplitOrder {
    static constexpr bool SPLIT = true;
    StaticOrder so; int nlat, nsub, KS, nkt, nMl, nNn, G, c, ntfull;
    __host__ __device__ void init(int Ml, int nctx, int N, int Ktiles, int KS_, int G_, int c_) { so.init(Ml, N, G_, c_); nlat = so.nwg; KS = KS_; nkt = Ktiles / KS_; nMl = Ml / BM; nNn = N / BM; nsub = nctx * nNn * KS_; G = G_; c = c_; ntfull = Ktiles; }
    __host__ __device__ __forceinline__ bool next(int i, Unit& u) const {
        const long L = (long)i * G + c;
        if (L < nlat) { so.next(i, u); return true; }
        const int sub = (int)(L - nlat); if (sub >= nsub) return false;
        const int tile = sub / KS, ks = sub - tile * KS; u.pm = nMl + tile / nNn; u.pn = (tile % nNn) | ((ks + 1) << 8); return true;
    }
    __device__ __forceinline__ void a_ready(const Unit&) const {}
    __device__ __forceinline__ void done(const Unit&) const {}
};

typedef __bf16 bf2_t __attribute__((ext_vector_type(2)));
typedef float f2_t __attribute__((ext_vector_type(2)));
__device__ __forceinline__ unsigned cvt_pk_bf16(float lo, float hi) { const f2_t v = {lo, hi}; return __builtin_bit_cast(unsigned, __builtin_convertvector(v, bf2_t)); }
typedef _Float16 h2_t __attribute__((ext_vector_type(2)));
__device__ __forceinline__ unsigned pk_h2(float a, float b) { unsigned ha, hb; asm volatile("v_cvt_f16_f32 %0, %1" : "=v"(ha) : "v"(a)); asm volatile("v_cvt_f16_f32 %0, %1" : "=v"(hb) : "v"(b)); return (ha & 0xffffu) | (hb << 16); }
__device__ __forceinline__ void unpack_h2(unsigned w, float& lo, float& hi) { const unsigned wh = w >> 16; asm volatile("v_cvt_f32_f16 %0, %1" : "=v"(lo) : "v"(w)); asm volatile("v_cvt_f32_f16 %0, %1" : "=v"(hi) : "v"(wh)); }
__device__ __forceinline__ void unpack_h8(const u32x4 w, float (&f)[8]) { unpack_h2(w.x, f[0], f[1]); unpack_h2(w.y, f[2], f[3]); unpack_h2(w.z, f[4], f[5]); unpack_h2(w.w, f[6], f[7]); }
__device__ __forceinline__ u32x4 pack_h8(const float (&f)[8]) { u32x4 w; w.x = pk_h2(f[0], f[1]); w.y = pk_h2(f[2], f[3]); w.z = pk_h2(f[4], f[5]); w.w = pk_h2(f[6], f[7]); return w; }
__device__ __forceinline__ float sigmoidf_(float x) { return __builtin_amdgcn_rcpf(1.0f + __expf(-x)); }

struct EpiStoreBf16 {
    static constexpr bool PERM = true, AFTER_DRAIN = false;
    bf16_t* O; int ldc; int row_off, col_off; float scale;
    __device__ __forceinline__ void operator()(const f32x4 (&acc)[2][2][4][2], const Unit& u, int wr, int wc, int fr, int fq) const {
        asm volatile("" : "+v"(fr), "+v"(fq));
        const int row0 = row_off + u.pm * BM + wr * 64 + fr, col0 = col_off + u.pn * BM + wc * 32 + 8 * fq;
#pragma unroll
        for (int ai = 0; ai < 2; ++ai)
#pragma unroll
            for (int m = 0; m < 4; ++m) { bf16_t* rowp = O + (size_t)(row0 + ai * HALF + m * 16) * ldc + col0;
#pragma unroll
                for (int bj = 0; bj < 2; ++bj) { const f32x4 v0 = acc[ai][bj][m][0] * scale, v1 = acc[ai][bj][m][1] * scale;
                    u32x4 w; w.x = cvt_pk_bf16(v0[0], v0[1]); w.y = cvt_pk_bf16(v0[2], v0[3]); w.z = cvt_pk_bf16(v1[0], v1[1]); w.w = cvt_pk_bf16(v1[2], v1[3]);
                    *(u32x4*)(rowp + bj * HALF) = w; } }
    }
};
struct EpiSwiGLU {
    static constexpr bool PERM = true, AFTER_DRAIN = false;
    bf16_t* Hb; int ldc;
    __device__ __forceinline__ void operator()(const f32x4 (&acc)[2][2][4][2], const Unit& u, int wr, int wc, int fr, int fq) const {
        asm volatile("" : "+v"(fr), "+v"(fq));
        const int row0 = u.pm * BM + wr * 64 + fr, col0 = u.pn * HALF + wc * 32 + 8 * fq;
#pragma unroll
        for (int ai = 0; ai < 2; ++ai)
#pragma unroll
            for (int m = 0; m < 4; ++m) { bf16_t* rowp = Hb + (size_t)(row0 + ai * HALF + m * 16) * ldc + col0;
                f32x4 h0, h1;
#pragma unroll
                for (int j = 0; j < 4; ++j) { const float g0 = acc[ai][0][m][0][j], g1 = acc[ai][0][m][1][j];
                    h0[j] = g0 * sigmoidf_(g0) * acc[ai][1][m][0][j]; h1[j] = g1 * sigmoidf_(g1) * acc[ai][1][m][1][j]; }
                u32x4 w; w.x = cvt_pk_bf16(h0[0], h0[1]); w.y = cvt_pk_bf16(h0[2], h0[3]); w.z = cvt_pk_bf16(h1[0], h1[1]); w.w = cvt_pk_bf16(h1[2], h1[3]);
                *(u32x4*)rowp = w; }
    }
};
struct EpiResGate {
    static constexpr bool PERM = true, AFTER_DRAIN = false;
    unsigned short* X; const float* gate; float* part; const float* Xin32;
    __device__ __forceinline__ void operator()(const f32x4 (&acc)[2][2][4][2], const Unit& u, int wr, int wc, int fr, int fq) const {
        asm volatile("" : "+v"(fr), "+v"(fq));
        if (u.pn >> 8) {
            const int row0 = (u.pm - 64) * BM + wr * 64 + fr, col0 = (u.pn & 255) * BM + wc * 32 + 8 * fq;
            float* pb_ = part + (size_t)((u.pn >> 8) - 1) * 512 * 2048;
#pragma unroll
            for (int ai = 0; ai < 2; ++ai)
#pragma unroll
                for (int m = 0; m < 4; ++m) { float* rowp = pb_ + (size_t)(row0 + ai * HALF + m * 16) * 2048 + col0;
#pragma unroll
                    for (int bj = 0; bj < 2; ++bj) { *(f32x4*)(rowp + bj * HALF) = acc[ai][bj][m][0]; *(f32x4*)(rowp + bj * HALF + 4) = acc[ai][bj][m][1]; } }
            return;
        }
        const int j = u.pm < 32 ? 0 : (u.pm < 64 ? 1 : 2);
        const int row0 = u.pm * BM + wr * 64 + fr, col0 = u.pn * BM + wc * 32 + 8 * fq;
        const float* gv = gate + (size_t)j * 12288 + col0;
        f32x4 gt[2][2];
#pragma unroll
        for (int bj = 0; bj < 2; ++bj)
#pragma unroll
            for (int n = 0; n < 2; ++n) gt[bj][n] = *(const f32x4*)(gv + bj * HALF + 4 * n);
#pragma unroll
        for (int ai = 0; ai < 2; ++ai)
#pragma unroll
            for (int m = 0; m < 4; ++m) { const size_t ro = (size_t)(row0 + ai * HALF + m * 16) * 2048 + col0;
#pragma unroll
                for (int bj = 0; bj < 2; ++bj) { float xv[8];
                    if (Xin32) { const f32x4 a0 = *(const f32x4*)(Xin32 + ro + bj * HALF), a1 = *(const f32x4*)(Xin32 + ro + bj * HALF + 4);
                        xv[0] = a0[0]; xv[1] = a0[1]; xv[2] = a0[2]; xv[3] = a0[3]; xv[4] = a1[0]; xv[5] = a1[1]; xv[6] = a1[2]; xv[7] = a1[3]; }
                    else unpack_h8(*(const u32x4*)(X + ro + bj * HALF), xv);
#pragma unroll
                    for (int e = 0; e < 8; ++e) xv[e] += gt[bj][e >> 2][e & 3] * acc[ai][bj][m][e >> 2][e & 3];
                    *(u32x4*)(X + ro + bj * HALF) = pack_h8(xv); }
                asm volatile("" ::: "memory"); }
    }
};
struct EpiLora1 {
    static constexpr bool PERM = false, AFTER_DRAIN = false;
    unsigned short* LW; bf16_t* AA; const float* w0; const float* a0; size_t dstride;
    __device__ __forceinline__ void operator()(const f32x4 (&acc)[2][2][4][2], const Unit& u, int wr, int wc, int fr, int fq) const {
        asm volatile("" : "+v"(fr), "+v"(fq));
        const int blk = u.pn >> 2, d = blk & 1;
        const int row0 = u.pm * BM + wr * 64 + fr, col0 = (u.pn & 3) * BM + wc * 32 + 4 * fq;
        const float* bvp = (blk < 2 ? w0 : a0) + d * 1024 + col0;
        f32x4 bv[2][2];
#pragma unroll
        for (int bj = 0; bj < 2; ++bj)
#pragma unroll
            for (int n = 0; n < 2; ++n) bv[bj][n] = *(const f32x4*)(bvp + bj * HALF + n * 16);
        if (blk < 2) {
            unsigned short* base = LW + (size_t)d * dstride;
#pragma unroll
            for (int ai = 0; ai < 2; ++ai)
#pragma unroll
                for (int m = 0; m < 4; ++m) { unsigned short* rowp = base + (size_t)(row0 + ai * HALF + m * 16) * 1024 + col0;
#pragma unroll
                    for (int bj = 0; bj < 2; ++bj)
#pragma unroll
                        for (int n = 0; n < 2; ++n) { f32x4 o;
#pragma unroll
                            for (int j = 0; j < 4; ++j) { const float x = bv[bj][n][j] + acc[ai][bj][m][n][j];
                                o[j] = x; }
                            u32x2 w; w.x = pk_h2(o[0], o[1]); w.y = pk_h2(o[2], o[3]); *(u32x2*)(rowp + bj * HALF + n * 16) = w; } }
        } else {
            bf16_t* base = AA + (size_t)d * dstride;
#pragma unroll
            for (int ai = 0; ai < 2; ++ai)
#pragma unroll
                for (int m = 0; m < 4; ++m) { bf16_t* rowp = base + (size_t)(row0 + ai * HALF + m * 16) * 1024 + col0;
#pragma unroll
                    for (int bj = 0; bj < 2; ++bj)
#pragma unroll
                        for (int n = 0; n < 2; ++n) { f32x4 o;
#pragma unroll
                            for (int j = 0; j < 4; ++j) o[j] = bv[bj][n][j] + acc[ai][bj][m][n][j];
                            u32x2 w; w.x = cvt_pk_bf16(o[0], o[1]); w.y = cvt_pk_bf16(o[2], o[3]);
                            *(u32x2*)(rowp + bj * HALF + n * 16) = w; } }
        }
    }
};

struct EpiFFT1 {
    static constexpr bool PERM = true, AFTER_DRAIN = false;
    bf16_t* D2;
    __device__ __forceinline__ void operator()(const f32x4 (&acc)[2][2][4][2], const Unit& u, int wr, int wc, int fr, int fq) const {
        asm volatile("" : "+v"(fr), "+v"(fq));
        const int l1 = 32 * (wc & 1) + 8 * fq;
#pragma unroll
        for (int mi = 0; mi < 4; ++mi) { const int l2p = wr * 64 + mi * 16 + fr;
#pragma unroll
            for (int bj = 0; bj < 2; ++bj) { const int nrow = 4 * u.pn + 2 * bj + (wc >> 1), b = nrow >> 9, ng = nrow & 511;
                float orr[8], oi[8];
#pragma unroll
                for (int e = 0; e < 8; ++e) { const float br = acc[0][bj][mi][e >> 2][e & 3], bi = acc[1][bj][mi][e >> 2][e & 3];
                    const float a = (float)((l1 + e) * l2p) * (1.0f / 8192.0f), ct = __builtin_amdgcn_cosf(a), st = __builtin_amdgcn_sinf(a);
                    orr[e] = br * ct + bi * st; oi[e] = bi * ct - br * st; }
                bf16_t* dst = D2 + (((size_t)(b * 128 + l2p) * 512 + ng) * 2) * 64 + l1;
                u32x4 w; w.x = cvt_pk_bf16(orr[0], orr[1]); w.y = cvt_pk_bf16(orr[2], orr[3]); w.z = cvt_pk_bf16(orr[4], orr[5]); w.w = cvt_pk_bf16(orr[6], orr[7]); *(u32x4*)dst = w;
                w.x = cvt_pk_bf16(oi[0], oi[1]); w.y = cvt_pk_bf16(oi[2], oi[3]); w.z = cvt_pk_bf16(oi[4], oi[5]); w.w = cvt_pk_bf16(oi[6], oi[7]); *(u32x4*)(dst + 64) = w; } }
    }
};
struct EpiFFT2 {
    static constexpr bool PERM = false, AFTER_DRAIN = false;
    bf16_t* MIXp; float scale;
    __device__ __forceinline__ void operator()(const f32x4 (&acc)[2][2][4][2], const Unit& u, int wr, int wc, int fr, int fq) const {
        asm volatile("" : "+v"(fr), "+v"(fq));
        if (wc < 2) {
#pragma unroll
            for (int ai = 0; ai < 2; ++ai)
#pragma unroll
                for (int mi = 0; mi < 4; ++mi) { const int r = u.pm * BM + 128 * ai + 64 * wr + 16 * mi + fr, b = r >> 16, l2p = (r >> 9) & 127, ng = r & 511;
                    bf16_t* base = MIXp + ((size_t)(b * 8192 + l2p)) * 2048 + 1536 + ng;
#pragma unroll
                    for (int n = 0; n < 2; ++n)
#pragma unroll
                        for (int j = 0; j < 4; ++j) { const int l1p = 32 * wc + 16 * n + 4 * fq + j;
                            base[(size_t)l1p * 128 * 2048] = (bf16_t)(cvt_pk_bf16(acc[ai][0][mi][n][j] * scale, 0.0f) & 0xffffu); } }
        }
    }
};

template <class Epi, class Sched, bool ALIGN_EPI = false, bool SP2 = false>
__device__ __forceinline__ void gemm_phase(PG8_LAS unsigned char* lds, const Gemm g, const Sched& S, const Epi& E, const int tid) {
    const int wid = __builtin_amdgcn_readfirstlane(tid >> 6), lane = tid & 63, wr = wid >> 2, wc = wid & 3, fr = lane & 15, fq = lane >> 4;
    const int K = g.K; int nt = K / BK;
    unsigned voffA[2], voffB[2];
#pragma unroll
    for (int i = 0; i < 2; ++i) { int R, C; stage_rc(tid * 16 + i * 8192, R, C); const int Rb = Epi::PERM ? ((R & ~31) + perm32(R & 31)) : R;
        voffA[i] = (unsigned)(R * g.lda + C) * 2u; voffB[i] = (unsigned)(Rb * g.ldb + C) * 2u; }
    const size_t kstep = (size_t)(BK * 2);
    const size_t hstepA = (size_t)HALF * g.lda * 2, hstepB = (size_t)HALF * g.ldb * 2;
    const size_t tstepA = 2 * hstepA, tstepB = 2 * hstepB;
    const unsigned ldsw = (unsigned)wid * 1024u;
    const int aoff = lds_byte(wr * 64 + fr, fq * 8), boff = lds_byte(wc * 32 + fr, fq * 8);
#define PG8_SA(b, h) (((b) * 2 + (h)) * HTB)
#define PG8_SB(b, h) ((4 + (b) * 2 + (h)) * HTB)
#define PG8_STAGE(bufoff, gbase, voff) do { _Pragma("unroll") for (int _i = 0; _i < 2; ++_i) \
        __builtin_amdgcn_global_load_lds((const unsigned*)((const char*)(gbase) + (voff)[_i]), (PG8_LAS unsigned*)(lds + (bufoff) + ldsw + _i * 8192), 16, 0, 0); } while (0)
#define PG8_LDA(dst, b, h) do { _Pragma("unroll") for (int m = 0; m < 4; ++m) _Pragma("unroll") for (int k = 0; k < 2; ++k) dst[m][k] = *(const PG8_LAS bf16x8*)(lds + PG8_SA(b, h) + aoff + m * 2048 + k * 1024); } while (0)
#define PG8_LDB(dst, b, h) do { _Pragma("unroll") for (int n = 0; n < 2; ++n) _Pragma("unroll") for (int k = 0; k < 2; ++k) dst[n][k] = *(const PG8_LAS bf16x8*)(lds + PG8_SB(b, h) + boff + n * 2048 + k * 1024); } while (0)
#define PG8_MMA(ai, bj, At, Bt) do { __builtin_amdgcn_s_setprio(1); _Pragma("unroll") for (int m = 0; m < 4; ++m) _Pragma("unroll") for (int n = 0; n < 2; ++n) _Pragma("unroll") for (int k = 0; k < 2; ++k) \
        acc[ai][bj][m][n] = __builtin_amdgcn_mfma_f32_16x16x32_bf16(Bt[n][k], At[m][k], acc[ai][bj][m][n], 0, 0, 0); __builtin_amdgcn_s_setprio(0); } while (0)
#define PG8_WAIT_V(n) asm volatile("s_waitcnt vmcnt(" #n ")" ::: "memory")
#define PG8_WAIT_L(n) asm volatile("s_waitcnt lgkmcnt(" #n ")" ::: "memory")
#define PG8_BAR __builtin_amdgcn_s_barrier()
#define PG8_SCHED __builtin_amdgcn_sched_barrier(0)
    Unit cur, nxt; int ui = 0;
    if (!S.next(0, cur)) return;
    f32x4 acc[2][2][4][2];
#pragma unroll
    for (int a = 0; a < 2; ++a)
#pragma unroll
        for (int b = 0; b < 2; ++b)
#pragma unroll
            for (int m = 0; m < 4; ++m)
#pragma unroll
                for (int n = 0; n < 2; ++n) acc[a][b][m][n] = (f32x4){0.f, 0.f, 0.f, 0.f};
    bf16x8 At[4][2], B0[2][2], B1[2][2];
    const char* cA = (const char*)g.A + (size_t)cur.pm * tstepA; const char* cB = (const char*)g.Bt + (size_t)(cur.pn & 255) * tstepB;
    if constexpr (Sched::SPLIT) { const int ks1 = cur.pn >> 8; if (ks1) { cA += (size_t)(ks1 - 1) * S.nkt * kstep; cB += (size_t)(ks1 - 1) * S.nkt * kstep; nt = S.nkt; } }
    S.a_ready(cur);
    if constexpr (SP2) {
        PG8_STAGE(PG8_SB(0, 0), cB, voffB); PG8_STAGE(PG8_SB(0, 1), cB + hstepB, voffB); PG8_STAGE(PG8_SA(0, 0), cA, voffA); PG8_STAGE(PG8_SA(0, 1), cA + hstepA, voffA);
        if (wr == 1) PG8_BAR;
        PG8_WAIT_V(2); PG8_BAR;
        PG8_STAGE(PG8_SB(1, 0), cB + kstep, voffB); PG8_STAGE(PG8_SA(1, 0), cA + kstep, voffA); PG8_STAGE(PG8_SB(1, 1), cB + hstepB + kstep, voffB);
        PG8_WAIT_V(6); PG8_BAR;
    } else {
        PG8_STAGE(PG8_SB(0, 0), cB, voffB); PG8_STAGE(PG8_SA(0, 0), cA, voffA); PG8_STAGE(PG8_SB(0, 1), cB + hstepB, voffB); PG8_STAGE(PG8_SA(0, 1), cA + hstepA, voffA);
        if (wr == 1) PG8_BAR;
        PG8_WAIT_V(4); PG8_BAR;
        PG8_STAGE(PG8_SB(1, 0), cB + kstep, voffB); PG8_STAGE(PG8_SA(1, 0), cA + kstep, voffA); PG8_STAGE(PG8_SB(1, 1), cB + hstepB + kstep, voffB);
        PG8_WAIT_V(6); PG8_BAR;
    }
    for (;;) {
        const bool has_next = S.next(ui + 1, nxt);
        const char* nA = has_next ? (const char*)g.A + (size_t)nxt.pm * tstepA : cA; const char* nB = has_next ? (const char*)g.Bt + (size_t)(nxt.pn & 255) * tstepB : cB;
        if constexpr (Sched::SPLIT) { const int ks1 = has_next ? (nxt.pn >> 8) : 0; if (ks1) { nA += (size_t)(ks1 - 1) * S.nkt * kstep; nB += (size_t)(ks1 - 1) * S.nkt * kstep; } }
#pragma clang loop unroll(disable)
        for (int t = 0; t < nt; t += 2) {
            const bool last = (t == nt - 2);
            const char* a1 = cA + (size_t)(t + 1) * kstep;
            const char* a2 = last ? nA : cA + (size_t)(t + 2) * kstep; const char* b2 = last ? nB : cB + (size_t)(t + 2) * kstep;
            const char* a3 = a2 + kstep; const char* b3 = b2 + kstep;
            if (last && has_next) S.a_ready(nxt);
            if constexpr (SP2) {
            PG8_LDB(B0, 0, 0); PG8_LDB(B1, 0, 1); PG8_SCHED; PG8_LDA(At, 0, 0); PG8_STAGE(PG8_SA(1, 1), a1 + hstepA, voffA);
            PG8_WAIT_V(8); PG8_WAIT_L(0); PG8_BAR; PG8_MMA(0, 0, At, B0); PG8_MMA(0, 1, At, B1); PG8_BAR; PG8_SCHED;
            PG8_LDA(At, 0, 1); PG8_STAGE(PG8_SB(0, 0), b2, voffB); PG8_STAGE(PG8_SB(0, 1), b2 + hstepB, voffB); PG8_STAGE(PG8_SA(0, 0), a2, voffA);
            PG8_WAIT_V(8); PG8_WAIT_L(0); PG8_BAR; PG8_MMA(1, 0, At, B0); PG8_MMA(1, 1, At, B1); PG8_BAR; PG8_SCHED;
            PG8_LDB(B0, 1, 0); PG8_LDB(B1, 1, 1); PG8_SCHED; PG8_LDA(At, 1, 0); PG8_STAGE(PG8_SA(0, 1), a2 + hstepA, voffA);
            PG8_WAIT_V(8); PG8_WAIT_L(0); PG8_BAR; PG8_MMA(0, 0, At, B0); PG8_MMA(0, 1, At, B1); PG8_BAR; PG8_SCHED;
            PG8_LDA(At, 1, 1); PG8_STAGE(PG8_SB(1, 0), b3, voffB); PG8_STAGE(PG8_SB(1, 1), b3 + hstepB, voffB); PG8_STAGE(PG8_SA(1, 0), a3, voffA);
            PG8_WAIT_V(8); PG8_WAIT_L(0); PG8_BAR; PG8_MMA(1, 0, At, B0); PG8_MMA(1, 1, At, B1); PG8_BAR; PG8_SCHED;
            } else {
            PG8_LDB(B0, 0, 0); PG8_SCHED; PG8_LDA(At, 0, 0); PG8_STAGE(PG8_SA(1, 1), a1 + hstepA, voffA);
            PG8_WAIT_L(8); PG8_BAR; PG8_WAIT_L(0); PG8_MMA(0, 0, At, B0); PG8_BAR; PG8_SCHED;
            PG8_LDB(B1, 0, 1); PG8_STAGE(PG8_SB(0, 0), b2, voffB);
            PG8_BAR; PG8_WAIT_L(0); PG8_MMA(0, 1, At, B1); PG8_BAR;
            PG8_LDA(At, 0, 1); PG8_STAGE(PG8_SA(0, 0), a2, voffA);
            PG8_BAR; PG8_WAIT_L(0); PG8_MMA(1, 0, At, B0); PG8_BAR; PG8_SCHED;
            PG8_STAGE(PG8_SB(0, 1), b2 + hstepB, voffB);
            PG8_WAIT_V(6); PG8_BAR; PG8_MMA(1, 1, At, B1); PG8_BAR;
            PG8_LDB(B0, 1, 0); PG8_SCHED; PG8_LDA(At, 1, 0); PG8_STAGE(PG8_SA(0, 1), a2 + hstepA, voffA);
            PG8_WAIT_L(8); PG8_BAR; PG8_WAIT_L(0); PG8_MMA(0, 0, At, B0); PG8_BAR; PG8_SCHED;
            PG8_LDB(B1, 1, 1); PG8_STAGE(PG8_SB(1, 0), b3, voffB);
            PG8_BAR; PG8_WAIT_L(0); PG8_MMA(0, 1, At, B1); PG8_BAR;
            PG8_LDA(At, 1, 1); PG8_STAGE(PG8_SA(1, 0), a3, voffA);
            PG8_BAR; PG8_WAIT_L(0); PG8_MMA(1, 0, At, B0); PG8_BAR; PG8_SCHED;
            PG8_STAGE(PG8_SB(1, 1), b3 + hstepB, voffB);
            PG8_WAIT_V(6); PG8_BAR; PG8_MMA(1, 1, At, B1); PG8_BAR;
            }
        }
        if constexpr (ALIGN_EPI) { if (wr == 0) PG8_BAR; }
        if constexpr (!Epi::AFTER_DRAIN) { E(acc, cur, wr, wc, fr, fq); S.done(cur); }
        if (!has_next) break;
#pragma unroll
        for (int a = 0; a < 2; ++a)
#pragma unroll
            for (int b = 0; b < 2; ++b)
#pragma unroll
                for (int m = 0; m < 4; ++m)
#pragma unroll
                    for (int n = 0; n < 2; ++n) acc[a][b][m][n] = (f32x4){0.f, 0.f, 0.f, 0.f};
        cur = nxt; cA = nA; cB = nB; ++ui; if constexpr (Sched::SPLIT) nt = (cur.pn >> 8) ? S.nkt : S.ntfull;
        if constexpr (ALIGN_EPI) { if (wr == 1) PG8_BAR; }
    }
    PG8_WAIT_V(0);
    if constexpr (!ALIGN_EPI) { if (wr == 0) PG8_BAR; }
    PG8_BAR;
#undef PG8_SA
#undef PG8_SB
#undef PG8_STAGE
#undef PG8_LDA
#undef PG8_LDB
#undef PG8_MMA
#undef PG8_WAIT_V
#undef PG8_WAIT_L
#undef PG8_BAR
#undef PG8_SCHED
}
}

constexpr int NWAVES = 8;
constexpr int DM = 2048, SEQ = 8192, NB = 2, DEPTH = 4, CTX = 256, HD = 64, NH = 16;
constexpr int DR = 1024, DC = 512, DF = 512;
constexpr int R0 = 0, K0 = 1024, V0 = 2048, WD0 = 3072, AD0 = 3168, GD0 = 3264, RWC = 3520;
constexpr int CG0 = 3520, CX0 = 4032, CB0 = 4544, FT0 = 5056, DIN = 5568, DINP = 5632;
constexpr int DFF = 5632;
constexpr int ML = NB * SEQ, MC = NB * CTX, MR = ML + MC;
constexpr int MODW = 6 * DM;
constexpr float RMS_EPS = 1e-6f, GN_EPS = 64e-5f, KK_EPS = 1e-12f;

constexpr size_t MiB = 1u << 20;
constexpr size_t WS_CTL = 0, CTL_ZERO_BYTES = 1 * MiB;
constexpr size_t WS_MOD = 1 * MiB;
constexpr size_t WS_MODP = 2 * MiB;
constexpr size_t WS_BONUS = 8 * MiB;
constexpr size_t WS_LA = 10 * MiB;
constexpr size_t WS_DFTC = 28 * MiB;
constexpr size_t WS_FTC = 29 * MiB;
constexpr size_t WS_WL1 = 30 * MiB;
constexpr size_t WS_WG = 32 * MiB;
constexpr size_t WS_X = 34 * MiB;
constexpr size_t WS_WIN = WS_X + 132 * MiB;
constexpr size_t WS_WOUT = WS_WIN + 22 * MiB;
constexpr size_t WS_WGU = WS_WOUT + 8 * MiB;
constexpr size_t WS_WDN = WS_WGU + 44 * MiB;
constexpr size_t WS_F1 = 33 * MiB;
constexpr size_t WS_F2 = 33 * MiB + 256 * 1024;
constexpr size_t WS_WSET = 96 * MiB;
constexpr size_t WS_R0 = WS_WDN + 22 * MiB + WS_WSET;
constexpr size_t HMiB = MiB / 2;
constexpr size_t WS_XN = WS_R0;
constexpr size_t WS_RS = WS_R0, WS_KK = WS_R0 + 33 * MiB;
constexpr size_t WS_H = WS_R0 + 66 * MiB;
constexpr size_t WS_PX = WS_H;
constexpr size_t WS_SCR1 = WS_R0 + 858 * MiB;
constexpr size_t WS_AA = WS_R0 + 495 * HMiB;
constexpr size_t WS_LW = WS_R0 + 627 * HMiB;
constexpr size_t WS_YF = WS_LW + 99 * MiB, WS_YB = WS_LW + 66 * MiB;
constexpr size_t WS_KD = WS_R0 + 891 * HMiB;
constexpr size_t WS_BH = WS_KD + 66 * MiB;
constexpr size_t WS_VS = WS_BH + 66 * MiB;
constexpr size_t WS_G = WS_VS + 33 * MiB;
constexpr size_t WS_MIX = WS_G + 33 * MiB;
constexpr size_t WS_SCR3 = WS_MIX + 66 * MiB;
constexpr size_t WS_D1 = WS_SCR3 + 17 * MiB;
constexpr size_t WS_D2 = WS_D1 + 32 * MiB;
constexpr size_t WS_PARTH = WS_SCR3 + 82 * MiB;
constexpr size_t WS_PARTK = WS_SCR3 + 98 * MiB;
constexpr size_t WS_COMP = WS_SCR3 + 114 * MiB;
constexpr size_t WS_END = WS_SCR1 + 495 * HMiB;
constexpr int NCH = 132;
constexpr int NSEG = 4, SEGLEN = NCH / NSEG;
constexpr size_t ITEM_BYTES = 32768;
constexpr int SCR1_ITEMS = 7920;
static_assert((size_t)SCR1_ITEMS * ITEM_BYTES == 495 * HMiB && (size_t)(64 * NCH - SCR1_ITEMS) * ITEM_BYTES <= 297 * HMiB, "scan scratch");
static_assert((size_t)MR * 2048 * 4 == 132 * MiB && (size_t)MR * 5632 * 2 <= 182 * MiB, "sizes");

constexpr size_t SCAN_FLAG_OFF = 65536;
constexpr int CW_BAR = 4096;

constexpr int RING_OFF = 0, RING_BYTES = 131072;
constexpr int LDSCTL_OFF = 139264, MISC_OFF = LDSCTL_OFF + 320;
constexpr int LDS_BYTES = 147456;

#define GAS __attribute__((address_space(1)))
#define LAS __attribute__((address_space(3)))
typedef unsigned short bf16;
typedef unsigned v4u __attribute__((ext_vector_type(4)));
typedef unsigned v2u __attribute__((ext_vector_type(2)));
typedef float f32x4 __attribute__((ext_vector_type(4)));
#define LDS_WAIT() asm volatile("s_waitcnt lgkmcnt(0)" ::: "memory")
#define VM_WAIT() asm volatile("s_waitcnt vmcnt(0)" ::: "memory")
__device__ __forceinline__ unsigned pk2(float lo, float hi) { return pg8::cvt_pk_bf16(lo, hi); }
__device__ __forceinline__ unsigned f2bf(float f) { return pg8::cvt_pk_bf16(f, 0.0f) & 0xffffu; }
__device__ __forceinline__ float bflo(unsigned w) { return __uint_as_float(w << 16); }
__device__ __forceinline__ float bfhi(unsigned w) { return __uint_as_float(w & 0xffff0000u); }
__device__ __forceinline__ float bf1(bf16 b) { return __uint_as_float(((unsigned)b) << 16); }
__device__ __forceinline__ void unpack8(const v4u w, float (&f)[8]) { f[0] = bflo(w.x); f[1] = bfhi(w.x); f[2] = bflo(w.y); f[3] = bfhi(w.y); f[4] = bflo(w.z); f[5] = bfhi(w.z); f[6] = bflo(w.w); f[7] = bfhi(w.w); }
__device__ __forceinline__ v4u pack8(const float (&f)[8]) { v4u w; w.x = pk2(f[0], f[1]); w.y = pk2(f[2], f[3]); w.z = pk2(f[4], f[5]); w.w = pk2(f[6], f[7]); return w; }
__device__ __forceinline__ float sigm(float x) { return __builtin_amdgcn_rcpf(1.0f + __expf(-x)); }
__device__ __forceinline__ float tanh_(float x) { return 1.0f - 2.0f * __builtin_amdgcn_rcpf(1.0f + __expf(2.0f * x)); }

#define XB_TMO      128
#define XB_XCNT(j)  (256  + 64 * (j))
#define XB_XSUB(j)  (1280 + 64 * (j))
#define XB_XGEN(j)  (2304 + 64 * (j))
#define XB_TOP      3328
#define XB_TOPGEN   3392
#define XCD_BAR_WORDS 3456
#define XB_SPIN_CAP (1u << 20)

__device__ __forceinline__ unsigned xb_ld(unsigned* p)              { return __hip_atomic_load(p, __ATOMIC_RELAXED, __HIP_MEMORY_SCOPE_AGENT); }
__device__ __forceinline__ unsigned xb_add(unsigned* p, unsigned v) { return __hip_atomic_fetch_add(p, v, __ATOMIC_RELAXED, __HIP_MEMORY_SCOPE_AGENT); }
__device__ __forceinline__ unsigned xb_xcc_id() { return (unsigned)__builtin_amdgcn_s_getreg((3 << 11) | 20) & 0xFu; }
#define XB_SPIN(cond, bar) do { unsigned _sp = 0; while (cond) { __builtin_amdgcn_s_sleep(1); \
    if ((++_sp & 255u) == 0u) { if (xb_ld(&(bar)[XB_TMO])) break; if (_sp > XB_SPIN_CAP) { atomicAdd(&(bar)[XB_TMO], 1u); break; } } } } while (0)

struct XcdBarrier { unsigned* bar; unsigned x; volatile LAS unsigned* st; };
__device__ __forceinline__ XcdBarrier xcd_barrier_post(unsigned* bar, volatile LAS unsigned* st) {
    XcdBarrier b; b.bar = bar; b.x = xb_xcc_id(); b.st = st;
    if (threadIdx.x == 0) (void)xb_add(&bar[XB_XCNT(b.x)], 1u);
    return b;
}
__device__ __forceinline__ void xcd_barrier_complete(unsigned* bar, unsigned x, unsigned& nloc, unsigned& nx) {
    const unsigned G = gridDim.x * gridDim.y * gridDim.z;
    unsigned sum, cnt, mine, sp = 0u;
    for (;;) {
        sum = 0u; cnt = 0u; mine = 0u;
#pragma unroll
        for (unsigned j = 0; j < 16; ++j) { const unsigned c = xb_ld(&bar[XB_XCNT(j)]); sum += c; cnt += (c > 0u) ? 1u : 0u; mine = (j == x) ? c : mine; }
        if (sum == G) break;
        __builtin_amdgcn_s_sleep(1);
        if ((++sp & 255u) == 0u) { if (xb_ld(&bar[XB_TMO])) break; if (sp > XB_SPIN_CAP) { atomicAdd(&bar[XB_TMO], 1u); break; } }
    }
    nloc = mine > 0u ? mine : 1u; nx = cnt > 0u ? cnt : 1u;
}
__device__ __forceinline__ void xcd_barrier(const XcdBarrier& b) {
    asm volatile("s_waitcnt vmcnt(0)" ::: "memory");
    __syncthreads();
    if (threadIdx.x == 0) {
        unsigned* bar = b.bar;
        __builtin_amdgcn_s_waitcnt(0);
        unsigned nloc = b.st[0], nx = b.st[1];
        if (nloc == 0u) { xcd_barrier_complete(bar, b.x, nloc, nx); b.st[0] = nloc; b.st[1] = nx; }
        const unsigned old = xb_add(&bar[XB_XSUB(b.x)], 1u);
        const unsigned gen = old / nloc;
        if (old + 1u == (gen + 1u) * nloc) {
            __builtin_amdgcn_fence(__ATOMIC_RELEASE, "agent");
            asm volatile("s_waitcnt vmcnt(0)" ::: "memory");
            const unsigned og = xb_add(&bar[XB_TOP], 1u);
            const unsigned tg = og / nx;
            if (og + 1u == (tg + 1u) * nx) xb_add(&bar[XB_TOPGEN], 1u);
            else XB_SPIN(xb_ld(&bar[XB_TOPGEN]) == tg, bar);
            __builtin_amdgcn_fence(__ATOMIC_ACQUIRE, "agent");
            xb_add(&bar[XB_XGEN(b.x)], 1u);
            asm volatile("s_waitcnt vmcnt(0)" ::: "memory");
        } else {
            XB_SPIN(xb_ld(&bar[XB_XGEN(b.x)]) == gen, bar);
            __builtin_amdgcn_fence(__ATOMIC_ACQUIRE, "agent");
            asm volatile("s_waitcnt vmcnt(0)" ::: "memory");
        }
    }
    __syncthreads();
}

__device__ __forceinline__ float shx(float v, int lane, int o) { return __uint_as_float(__builtin_amdgcn_ds_bpermute((lane ^ o) << 2, __float_as_uint(v))); }
__device__ __forceinline__ float wave_sum(float v, int lane) {
#pragma unroll
    for (int o = 1; o < 64; o <<= 1) v += shx(v, lane, o);
    return v;
}
__device__ __forceinline__ float sum16(float v, int lane) {
#pragma unroll
    for (int o = 1; o < 16; o <<= 1) v += shx(v, lane, o);
    return v;
}
__device__ __forceinline__ void row_seg(int r, int& t, int& len) { if (r < ML) { t = r & (SEQ - 1); len = SEQ; } else { t = (r - ML) & (CTX - 1); len = CTX; } }

__device__ __forceinline__ void transpose_item(const float* W, int N, bf16* WT, int ldk, int k0, int n0, int drow0, LAS float* scr, int lane) {
    float tv_[32];
    const float* wp_ = W + (size_t)(k0 + (lane >> 5)) * N + n0 + (lane & 31);
#pragma unroll
    for (int i = 0; i < 32; ++i) tv_[i] = __builtin_nontemporal_load(wp_ + (size_t)(2 * i) * N);
#pragma unroll
    for (int i = 0; i < 32; ++i) scr[(2 * i + (lane >> 5)) * 33 + (lane & 31)] = tv_[i];
    LDS_WAIT(); asm volatile("" ::: "memory");
    const int c = lane & 7;
#pragma unroll
    for (int j = 0; j < 4; ++j) { const int n = (lane >> 3) + 8 * j; const LAS float* s = scr + (8 * c) * 33 + n;
        v4u o; o.x = pk2(s[0 * 33], s[1 * 33]); o.y = pk2(s[2 * 33], s[3 * 33]); o.z = pk2(s[4 * 33], s[5 * 33]); o.w = pk2(s[6 * 33], s[7 * 33]);
        *(v4u*)(WT + (size_t)(drow0 + n) * ldk + k0 + 8 * c) = o; }
    LDS_WAIT(); asm volatile("" ::: "memory");
}

__device__ __forceinline__ void norm_row_bf16(const float* xrow, const float* g, const float* shift, const float* scale, bf16* orow, int lane) {
    const f32x4* xr = (const f32x4*)xrow + lane;
    f32x4 v[8]; float s = 0.f;
#pragma unroll
    for (int j = 0; j < 8; ++j) { v[j] = xr[64 * j]; s += (v[j].x * v[j].x + v[j].y * v[j].y) + (v[j].z * v[j].z + v[j].w * v[j].w); }
    const float rstd = 1.0f / sqrtf(wave_sum(s, lane) * (1.0f / DM) + RMS_EPS);
    unsigned long long* o8 = (unsigned long long*)orow + lane;
#pragma unroll
    for (int j = 0; j < 8; ++j) { const int c4 = 64 * j + lane;
        const f32x4 gg = ((const f32x4*)g)[c4], sh = ((const f32x4*)shift)[c4], sc = ((const f32x4*)scale)[c4];
        f32x4 y = v[j] * rstd * gg; y = y * (1.0f + sc) + sh;
        o8[64 * j] = (unsigned long long)pk2(y.x, y.y) | ((unsigned long long)pk2(y.z, y.w) << 32); }
}

__device__ __forceinline__ pg8::bf16x8 ldf(LAS const unsigned char* buf, int rb, int ks, int g, int c) { return *(LAS const pg8::bf16x8*)(buf + (16 * rb + c) * 144 + (32 * ks + 8 * g) * 2); }
__device__ __forceinline__ f32x4 mm(LAS const unsigned char* A, int ra, LAS const unsigned char* B, int rbk, int g, int c, f32x4 acc) {
    acc = __builtin_amdgcn_mfma_f32_16x16x32_bf16(ldf(A, ra, 0, g, c), ldf(B, rbk, 0, g, c), acc, 0, 0, 0);
    acc = __builtin_amdgcn_mfma_f32_16x16x32_bf16(ldf(A, ra, 1, g, c), ldf(B, rbk, 1, g, c), acc, 0, 0, 0);
    return acc; }
__device__ __forceinline__ float wave_incl_scan(float v) {
#define DPP_ADD(ctrl, rmask, bc) v += __uint_as_float(__builtin_amdgcn_update_dpp(0u, __float_as_uint(v), (ctrl), (rmask), 0xf, (bc)))
    DPP_ADD(0x111, 0xf, true); DPP_ADD(0x112, 0xf, true); DPP_ADD(0x114, 0xf, true); DPP_ADD(0x118, 0xf, true);
    DPP_ADD(0x142, 0xa, false); DPP_ADD(0x143, 0xc, false);
#undef DPP_ADD
    return v;
}
struct Fr2 { pg8::bf16x8 k0, k1; };
__device__ __forceinline__ Fr2 ldf2(LAS const unsigned char* buf, int rb, int g, int c) { Fr2 f; f.k0 = ldf(buf, rb, 0, g, c); f.k1 = ldf(buf, rb, 1, g, c); return f; }
__device__ __forceinline__ f32x4 mmf(const Fr2& A, const Fr2& B, f32x4 acc) {
    acc = __builtin_amdgcn_mfma_f32_16x16x32_bf16(A.k0, B.k0, acc, 0, 0, 0); acc = __builtin_amdgcn_mfma_f32_16x16x32_bf16(A.k1, B.k1, acc, 0, 0, 0); return acc; }
__device__ __forceinline__ Fr2 ldf2_tr(LAS const unsigned char* buf, int rb, int g, int c) {
    typedef short s4_t __attribute__((ext_vector_type(4)));
    LAS const unsigned char* p = buf + (8 * g + (c >> 2)) * 144 + (16 * rb + 4 * (c & 3)) * 2;
    const s4_t a0 = __builtin_amdgcn_ds_read_tr16_b64_v4i16((LAS s4_t*)(p)), a1 = __builtin_amdgcn_ds_read_tr16_b64_v4i16((LAS s4_t*)(p + 4 * 144));
    const s4_t b0 = __builtin_amdgcn_ds_read_tr16_b64_v4i16((LAS s4_t*)(p + 32 * 144)), b1 = __builtin_amdgcn_ds_read_tr16_b64_v4i16((LAS s4_t*)(p + 36 * 144));
    Fr2 f; f.k0 = __builtin_shufflevector(a0, a1, 0, 1, 2, 3, 4, 5, 6, 7); f.k1 = __builtin_shufflevector(b0, b1, 0, 1, 2, 3, 4, 5, 6, 7); return f;
}
__device__ __forceinline__ pg8::bf16x8 ldf_tr(LAS const unsigned char* buf, int rb, int ks, int g, int c) {
    typedef short s4_t __attribute__((ext_vector_type(4)));
    LAS const unsigned char* p = buf + (32 * ks + 8 * g + (c >> 2)) * 144 + (16 * rb + 4 * (c & 3)) * 2;
    const s4_t a0 = __builtin_amdgcn_ds_read_tr16_b64_v4i16((LAS s4_t*)(p)), a1 = __builtin_amdgcn_ds_read_tr16_b64_v4i16((LAS s4_t*)(p + 4 * 144));
    return __builtin_shufflevector(a0, a1, 0, 1, 2, 3, 4, 5, 6, 7);
}
__device__ __forceinline__ v2u pack4(f32x4 a) { v2u w; w.x = pg8::cvt_pk_bf16(a[0], a[1]); w.y = pg8::cvt_pk_bf16(a[2], a[3]); return w; }
__device__ __forceinline__ void st_nat(LAS unsigned char* buf, int mt, int nt, int g, int c, f32x4 a) { *(LAS v2u*)(buf + (16 * mt + c) * 144 + (16 * nt + 4 * g) * 2) = pack4(a); }
__device__ __forceinline__ void st_tr(LAS unsigned char* buf, int mt, int nt, int g, int c, f32x4 a) { *(LAS v2u*)(buf + (16 * nt + c) * 144 + (16 * mt + 4 * g) * 2) = pack4(a); }

__device__ __forceinline__ void ctx_row_add_partials(unsigned short* xrow, const float* xsrc32, const float* prow, const float* gatev, int lane) {
#pragma unroll
    for (int jj = 0; jj < 4; ++jj) { const int c8 = 8 * (64 * jj + lane); float xv[8]; f32x4 s0 = *(const f32x4*)(prow + c8), s1 = *(const f32x4*)(prow + c8 + 4);
#pragma unroll
        for (int ks = 1; ks < 4; ++ks) { s0 += *(const f32x4*)(prow + (size_t)ks * 512 * 2048 + c8); s1 += *(const f32x4*)(prow + (size_t)ks * 512 * 2048 + c8 + 4); }
        if (xsrc32) { const f32x4 a0 = *(const f32x4*)(xsrc32 + c8), a1 = *(const f32x4*)(xsrc32 + c8 + 4); xv[0] = a0[0]; xv[1] = a0[1]; xv[2] = a0[2]; xv[3] = a0[3]; xv[4] = a1[0]; xv[5] = a1[1]; xv[6] = a1[2]; xv[7] = a1[3]; }
        else pg8::unpack_h8(*(const v4u*)(xrow + c8), xv);
        const f32x4 g0 = *(const f32x4*)(gatev + c8), g1 = *(const f32x4*)(gatev + c8 + 4);
#pragma unroll
        for (int e = 0; e < 4; ++e) { xv[e] += g0[e] * s0[e]; xv[4 + e] += g1[e] * s1[e]; }
        *(v4u*)(xrow + c8) = pg8::pack_h8(xv); }
}

#define NORM_ROWS(gptr, sh_off, sc_off, X32, PARTCALL) do { \
    for (int j_ = 0; j_ < 3; ++j_) { const float* mv_ = MODL + (size_t)j_ * MODW; f32x4 gg_[4][2], shv_[4][2]; \
        _Pragma("unroll") for (int jj = 0; jj < 4; ++jj) _Pragma("unroll") for (int hh = 0; hh < 2; ++hh) { const int c4 = 8 * (64 * jj + lane) + 4 * hh; \
            gg_[jj][hh] = *(const f32x4*)((gptr) + c4) * (1.0f + *(const f32x4*)(mv_ + (sc_off) + c4)); shv_[jj][hh] = *(const f32x4*)(mv_ + (sh_off) + c4); } \
        const int r0_ = j_ == 0 ? 0 : (j_ == 1 ? SEQ : ML), r1_ = j_ == 0 ? SEQ : (j_ == 1 ? ML : MR); \
        for (int ra_ = r0_ + gw; ra_ < r1_; ra_ += 2 * NGW) {        \
            const bool vb_ = ra_ + NGW < r1_; \
            { const int r = ra_; PARTCALL; } if (vb_) { const int r = ra_ + NGW; PARTCALL; } \
            float v_[2][4][8]; bool is32_; { const int r = ra_; is32_ = (X32) != nullptr; } \
            if (is32_) { \
                _Pragma("unroll") for (int i_ = 0; i_ < 2; ++i_) { const int r = vb_ ? ra_ + i_ * NGW : ra_; const float* x32_ = (X32); \
                    _Pragma("unroll") for (int jj = 0; jj < 4; ++jj) { const int c8 = 8 * (64 * jj + lane); const f32x4 a0 = *(const f32x4*)(x32_ + c8), a1 = *(const f32x4*)(x32_ + c8 + 4); \
                        v_[i_][jj][0] = a0[0]; v_[i_][jj][1] = a0[1]; v_[i_][jj][2] = a0[2]; v_[i_][jj][3] = a0[3]; v_[i_][jj][4] = a1[0]; v_[i_][jj][5] = a1[1]; v_[i_][jj][6] = a1[2]; v_[i_][jj][7] = a1[3]; } } \
            } else { v4u w16_[2][4]; \
                _Pragma("unroll") for (int i_ = 0; i_ < 2; ++i_) { const int r = vb_ ? ra_ + i_ * NGW : ra_; const unsigned short* x16_ = W_(unsigned short, WS_X) + (size_t)r * DM; \
                    _Pragma("unroll") for (int jj = 0; jj < 4; ++jj) w16_[i_][jj] = *(const v4u*)(x16_ + 8 * (64 * jj + lane)); } \
                _Pragma("unroll") for (int i_ = 0; i_ < 2; ++i_) _Pragma("unroll") for (int jj = 0; jj < 4; ++jj) pg8::unpack_h8(w16_[i_][jj], v_[i_][jj]); } \
            _Pragma("unroll") for (int i_ = 0; i_ < 2; ++i_) { const int r = ra_ + i_ * NGW; float s_ = 0.f; \
                _Pragma("unroll") for (int jj = 0; jj < 4; ++jj) _Pragma("unroll") for (int e = 0; e < 8; ++e) s_ += v_[i_][jj][e] * v_[i_][jj][e]; \
                const float rstd_ = 1.0f / sqrtf(wave_sum(s_, lane) * (1.0f / DM) + RMS_EPS); \
                if (i_ == 0 || vb_) { bf16* o_ = W_(bf16, WS_XN) + (size_t)r * DM; \
                    _Pragma("unroll") for (int jj = 0; jj < 4; ++jj) { float y_[8]; \
                        _Pragma("unroll") for (int e = 0; e < 8; ++e) y_[e] = v_[i_][jj][e] * rstd_ * gg_[jj][e >> 2][e & 3] + shv_[jj][e >> 2][e & 3]; \
                        *(v4u*)(o_ + 8 * (64 * jj + lane)) = pack8(y_); } } } } } } while (0)

constexpr int CVT_NIT = 32 * 174 + 32 * 64 + 2 * 32 * 176 + 88 * 64;
constexpr int CVT_Q1 = 6400, CVT_Q2 = 18900;
#define CONVERT_WEIGHTS(LL, widx, nwk, scr) CONVERT_WEIGHTS_RANGE(LL, 0, CVT_NIT, true, widx, nwk, scr)
#define CONVERT_WEIGHTS_RANGE(LL, it0, it1, zfill, widx, nwk, scr) do { \
    constexpr int I_IN = 32 * 174, I_OUT = 32 * 64, I_G = 32 * 176, I_DN = 88 * 64; constexpr int NIT = I_IN + I_OUT + 2 * I_G + I_DN; \
    const size_t wso = (size_t)((LL) & 1) * WS_WSET; \
    const float* wi = INP(7) + (size_t)(LL) * DM * DIN; const float* wo = INP(20) + (size_t)(LL) * DM * DM; \
    const float* wg = INP(22) + (size_t)(LL) * DM * DFF; const float* wu = INP(23) + (size_t)(LL) * DM * DFF; const float* wd = INP(24) + (size_t)(LL) * DFF * DM; \
    static_assert(NIT == CVT_NIT, "CVT_NIT"); \
    for (int it = (it0) + (widx); it < (it1); it += (nwk)) { int r = it; \
        if (r < I_IN) { const int kb = r / 174, nb = r % 174; transpose_item(wi, DIN, W_(bf16, WS_WIN + wso), DM, 64 * kb, 32 * nb, 32 * nb, scr, lane); continue; } r -= I_IN; \
        if (r < I_OUT) { const int kb = r / 64, nb = r % 64; transpose_item(wo, DM, W_(bf16, WS_WOUT + wso), DM, 64 * kb, 32 * nb, 32 * nb, scr, lane); continue; } r -= I_OUT; \
        if (r < I_G) { const int kb = r / 176, nb = r % 176, n0 = 32 * nb; transpose_item(wg, DFF, W_(bf16, WS_WGU + wso), DM, 64 * kb, n0, (n0 >> 7) * 256 + (n0 & 127), scr, lane); continue; } r -= I_G; \
        if (r < I_G) { const int kb = r / 176, nb = r % 176, n0 = 32 * nb; transpose_item(wu, DFF, W_(bf16, WS_WGU + wso), DM, 64 * kb, n0, (n0 >> 7) * 256 + 128 + (n0 & 127), scr, lane); continue; } r -= I_G; \
        { const int kb = r / 64, nb = r % 64; transpose_item(wd, DM, W_(bf16, WS_WDN + wso), DFF, 64 * kb, 32 * nb, 32 * nb, scr, lane); } } \
    if (zfill) for (int i = (widx) * 64 + lane; i < 64 * DM / 8; i += (nwk) * 64) ((v4u*)(W_(bf16, WS_WIN + wso) + (size_t)DIN * DM))[i] = (v4u){(unsigned)oz, (unsigned)oz, (unsigned)oz, (unsigned)oz}; \
    } while (0)

struct Args { const float* in[26]; float* out; unsigned char* ws; int ph_lo, ph_hi; };
constexpr int PH_PER_LAYER = 13;
constexpr int NPHASES = 2 + DEPTH * PH_PER_LAYER + 1;

__global__ void __launch_bounds__(NWAVES * 64, 2) skel_fwd(Args args) {
    extern __shared__ __attribute__((aligned(16))) unsigned char lds_raw[];
    LAS unsigned char* lds = (LAS unsigned char*)lds_raw;
    volatile LAS unsigned* MISC = (volatile LAS unsigned*)(lds + MISC_OFF);
    const int tid0 = threadIdx.x, G0 = gridDim.x, bx0 = blockIdx.x;
    const int wave0 = __builtin_amdgcn_readfirstlane(tid0 >> 6);
    unsigned char* ws = args.ws;
    for (int u = tid0; u < (LDS_BYTES - LDSCTL_OFF) / 4; u += NWAVES * 64) ((LAS unsigned*)(lds + LDSCTL_OFF))[u] = 0u;
    __syncthreads();
#if MK_ONE_LAUNCH
    XcdBarrier bar = xcd_barrier_post((unsigned*)(ws + WS_CTL) + CW_BAR, MISC + 8);
#define GRID_BAR() xcd_barrier(bar)
#else
#define GRID_BAR() do {} while (0)
#endif
    const int lo = args.ph_lo, hi = args.ph_hi;
#define IN(k) (lo <= (k) && (k) < hi)
#define ENDPH(k) do { if (IN((k)) && IN((k) + 1)) GRID_BAR(); } while (0)

    constexpr size_t DSTR = (size_t)MR * 1024;

#define PH_BEGIN unsigned char* wsp = args.ws; asm volatile("" : "+s"(wsp)); GAS unsigned char* wsg = (GAS unsigned char*)wsp; int oz; asm volatile("s_mov_b32 %0, 0" : "=s"(oz)); \
    int wv_ = wave0, bx = bx0, G = G0; asm volatile("" : "+s"(bx), "+s"(G), "+s"(wv_)); int ln_; asm volatile("v_mbcnt_lo_u32_b32 %0, -1, 0\n\tv_mbcnt_hi_u32_b32 %0, -1, %0" : "=v"(ln_)); int tid = (wv_ << 6) | ln_; \
    const int lane = tid & 63, wave = __builtin_amdgcn_readfirstlane(tid >> 6); \
    const int gw = bx * NWAVES + wave, NGW = G * NWAVES, gt = bx * (NWAVES * 64) + tid, NGT = G * NWAVES * 64; \
    (void)lane; (void)gw; (void)NGW; (void)gt; (void)NGT; (void)oz;
#define W_(T, off) ((T*)(GAS T*)(wsg + (off)))
#define INP(i) ((const float*)(const GAS float*)args.in[(i) + oz])
#define MODL (W_(float, WS_MOD) + (size_t)l * 3 * MODW)
    if (IN(0)) { PH_BEGIN
        LAS float* sl = (LAS float*)lds;
        for (int i = tid; i < 3 * DM; i += NWAVES * 64) { const float v = i < 2 * DM ? INP(1)[i] : INP(3)[i - 2 * DM]; sl[i] = v * sigm(v); }
        __syncthreads();
        for (int it = gw; it < 4 * 48 * 8; it += NGW) {
            const int l = it / 384, rem = it % 384, cg = rem >> 3, ks = rem & 7;
            const float* W = INP(4) + ((size_t)l * DM + ks * 256) * MODW + cg * 256 + lane * 4;
            f32x4 a0 = {0.f, 0.f, 0.f, 0.f}, a1 = a0, a2 = a0;
#pragma unroll 8
            for (int k = 0; k < 256; ++k) { const f32x4 w = __builtin_nontemporal_load((const f32x4*)(W + (size_t)k * MODW));
                a0 += w * sl[ks * 256 + k]; a1 += w * sl[DM + ks * 256 + k]; a2 += w * sl[2 * DM + ks * 256 + k]; }
            float* o = W_(float, WS_MODP) + ((size_t)(ks * 4 + l) * 3) * MODW + cg * 256 + lane * 4;
            *(f32x4*)(o) = a0; *(f32x4*)(o + MODW) = a1; *(f32x4*)(o + 2 * MODW) = a2;
        }
        for (int i = gt; i < 65536; i += NGT) { const int m = i >> 8, k = i & 255, rip = m >> 7, l2p = m & 127, ri = k >> 7, l2 = k & 127;
            const float a = (float)((l2 * l2p) & 127) * (1.0f / 128.0f), cv = __builtin_amdgcn_cosf(a), sv = __builtin_amdgcn_sinf(a);
            W_(bf16, WS_F1)[i] = (bf16)f2bf(rip == ri ? cv : (rip == 0 ? sv : -sv)); }
        for (int i = gt; i < 32768; i += NGT) { const int n = i >> 7, k = i & 127, rip = k >> 6, l1 = k & 63;
            const float a = (float)((l1 * n) & 63) * (1.0f / 64.0f); const float v = n < 64 ? (rip == 0 ? __builtin_amdgcn_cosf(a) : __builtin_amdgcn_sinf(a)) : 0.0f;
            W_(bf16, WS_F2)[i] = (bf16)f2bf(v); }
        for (int i = gt; i < CTX * 512 / 8; i += NGT) {
            const int lp = i >> 6, k0 = (i & 63) * 8; float f[8];
#pragma unroll
            for (int j = 0; j < 8; ++j) { const int k = k0 + j; const int m = (lp * (k & (CTX - 1))) & (CTX - 1); const float a = (float)m * (1.0f / CTX);
                f[j] = k < CTX ? __builtin_amdgcn_cosf(a) : -__builtin_amdgcn_sinf(a); }
            *(v4u*)(W_(bf16, WS_DFTC) + (size_t)i * 8) = pack8(f);
        }
        __syncthreads();
        { LAS float* scr = (LAS float*)(lds + RING_OFF + wave * 16384); CONVERT_WEIGHTS(0, gw, NGW, scr); }
        __syncthreads();
    }
    ENDPH(0);
    if (IN(1)) { PH_BEGIN
        for (int i = gt; i < 4 * 3 * MODW; i += NGT) { const int l = i / (3 * MODW), col = i % MODW; float s = INP(5)[l * MODW + col];
#pragma unroll
            for (int ks = 0; ks < 8; ++ks) s += W_(float, WS_MODP)[(size_t)ks * 4 * 3 * MODW + i];
            W_(float, WS_MOD)[i] = s; }
    }
    ENDPH(1);

#define TAIL_CONVERT(nunits, it0, it1, zfill) do { if (l + 1 < DEPTH) { const int fi_ = (nunits) - ((nunits) - 1) / G * G, first_idle = fi_ >= G ? 0 : fi_; \
    if (bx >= first_idle) { asm volatile("" : "+v"(tid)); __syncthreads(); LAS float* scr = (LAS float*)(lds + RING_OFF + wave * 16384); \
        CONVERT_WEIGHTS_RANGE(l + 1, it0, it1, zfill, (bx - first_idle) * NWAVES + wave, (G - first_idle) * NWAVES, scr); } } } while (0)
    for (int l = 0; l < DEPTH; ++l) {
        const int pb = 2 + l * PH_PER_LAYER;
        if (IN(pb + 0)) { PH_BEGIN
            for (int i = gt; i < 4 * 32 * 1024; i += NGT) { const int c = i & 1023, ko = (i >> 10) & 31, blk = i >> 15; float f[8];
                const bool dat = blk < 2 ? ko < 12 : (ko >= 12 && ko < 24);
                const float* sp = blk < 2 ? INP(10) + (((size_t)l * 2 + blk) * 96 + ko * 8) * 1024 + c : INP(12) + (((size_t)l * 2 + (blk - 2)) * 96 + (ko - 12) * 8) * 1024 + c;
#pragma unroll
                for (int e = 0; e < 8; ++e) f[e] = dat ? sp[(size_t)e * 1024] : 0.f;
                *(v4u*)(W_(bf16, WS_WL1) + ((size_t)(blk * 1024 + c) * 256 + ko * 8)) = pack8(f); }
            for (int i = gt; i < 32 * 1024; i += NGT) { const int c = i & 1023, ko = i >> 10; float f[8];
#pragma unroll
                for (int e = 0; e < 8; ++e) f[e] = INP(18)[((size_t)l * 256 + ko * 8 + e) * 1024 + c];
                *(v4u*)(W_(bf16, WS_WG) + ((size_t)c * 256 + ko * 8)) = pack8(f); }
            NORM_ROWS(INP(6) + (size_t)l * DM, 0, DM, (l == 0 ? (r < ML ? INP(0) + (size_t)r * DM : INP(2) + (size_t)(r - ML) * DM) : (const float*)nullptr),
                      if (r >= ML && l > 0) ctx_row_add_partials(W_(unsigned short, WS_X) + (size_t)r * DM, nullptr, W_(float, WS_PARTK) + (size_t)(r - ML) * DM, W_(float, WS_MOD) + (size_t)(l - 1) * 3 * MODW + 2 * MODW + 5 * DM, lane));
            __syncthreads();
        }
        ENDPH(pb + 0);
        if (IN(pb + 1)) { PH_BEGIN
            pg8::Gemm g{W_(bf16, WS_XN), W_(bf16, WS_WIN + (size_t)(l & 1) * WS_WSET), MR, DINP, DM, DM, DM}; pg8::StaticOrder S; S.init(MR, DINP, G, bx);
            pg8::EpiStoreBf16 E{W_(bf16, WS_PX), DINP, 0, 0, 1.0f};
            pg8::gemm_phase<pg8::EpiStoreBf16, pg8::StaticOrder, true, true>(lds + RING_OFF, g, S, E, tid);
            TAIL_CONVERT(S.nwg, 0, CVT_Q1, true);
        }
        ENDPH(pb + 1);
        if (IN(pb + 2)) { PH_BEGIN
            const float* sh = INP(8) + (size_t)l * 3 * RWC; const float* cw = INP(19) + (size_t)l * 3 * DC;
            { const int cv = gt & 63, dcol = cv * 8; const int zero = (cv >= 24 && cv < 32); const int sc = WD0 + (cv < 24 ? dcol : dcol - 64);
              float c0[8], c1[8], c2[8];
#pragma unroll
              for (int j = 0; j < 8; ++j) { c0[j] = zero ? 0.f : sh[sc + j]; c1[j] = zero ? 0.f : sh[RWC + sc + j]; c2[j] = zero ? 0.f : sh[2 * RWC + sc + j]; }
              constexpr int RB = 3;
              const int nx_ = 272 > G ? (272 - G < G ? 272 - G : 0) : 0;
              const int rw0 = (gt >> 6) - nx_ * NWAVES, rws = (NGT >> 6) - nx_ * NWAVES;
              for (int r0 = bx >= nx_ ? rw0 : MR; r0 < MR; r0 += RB * rws) {
                  v4u wc_[RB], wp_[RB], wn_[RB];
#pragma unroll
                  for (int i = 0; i < RB; ++i) { const int rr = r0 + i * rws, r = rr < MR ? rr : MR - 1; int t, len; row_seg(r, t, len);
                      const bf16* p = W_(bf16, WS_PX) + (size_t)r * DINP + sc; wc_[i] = (v4u){0u, 0u, 0u, 0u}; wp_[i] = wc_[i]; wn_[i] = wc_[i];
                      if (!zero) { wc_[i] = *(const v4u*)p; if (t > 0) wp_[i] = *(const v4u*)(p - DINP); if (t < len - 1) wn_[i] = *(const v4u*)(p + DINP); } }
#pragma unroll
                  for (int i = 0; i < RB; ++i) { const int r = r0 + i * rws;
                      if (r < MR) { float o[8], cur[8], prv[8], nxt[8]; unpack8(wc_[i], cur); unpack8(wp_[i], prv); unpack8(wn_[i], nxt);
#pragma unroll
                          for (int j = 0; j < 8; ++j) { const float s = c0[j] * prv[j] + c1[j] * cur[j] + c2[j] * nxt[j]; o[j] = zero ? 0.f : (cv < 12 ? tanh_(s) : (cv < 24 ? s : sigm(s))); }
                          *(v4u*)(W_(bf16, WS_LA) + (size_t)r * 512 + dcol) = pack8(o); } } } }
            { constexpr int SBB = 9216;
              LAS unsigned char* Cm = lds + 8 * SBB; LAS unsigned char* Sm = lds + 9 * SBB;
              __syncthreads();
              for (int i = tid; i < 4096; i += NWAVES * 64) { const int cp = i >> 6, cc = i & 63; const float a = (float)((cp * cc) & 63) * (1.0f / 64.0f);
                  *(LAS unsigned short*)(Cm + cp * 144 + cc * 2) = (unsigned short)f2bf(__builtin_amdgcn_cosf(a)); *(LAS unsigned short*)(Sm + cp * 144 + cc * 2) = (unsigned short)f2bf(__builtin_amdgcn_sinf(a)); }
              const int g = lane >> 4, c = lane & 15, mt = wave & 3, nt0 = 2 * (wave >> 2);
              for (int it = bx; it < 272; it += G) {
                  int b, gI, q = 0, nblk, row0;
                  if (it < 256) { b = it >> 7; gI = (it >> 4) & 7; q = it & 15; nblk = 8; row0 = b * SEQ + q * 512; } else { const int j = it - 256; b = j >> 3; gI = j & 7; nblk = 4; row0 = ML + b * CTX; }
                  __syncthreads();
                  for (int v = tid; v < nblk * 512; v += NWAVES * 64) { const int blk = v >> 9, row = (v >> 3) & 63, cv = v & 7;
                      *(LAS v4u*)(lds + blk * SBB + row * 144 + cv * 16) = *(const v4u*)(W_(bf16, WS_PX) + (size_t)(row0 + blk * 64 + row) * DINP + FT0 + gI * 64 + cv * 8); }
                  __syncthreads();
#pragma unroll
                  for (int q2 = 0; q2 < 2; ++q2) { const int nt = nt0 + q2; const f32x4 z4 = {0.f, 0.f, 0.f, 0.f}; f32x4 aC[8], aS[8];
#pragma unroll
                      for (int blk = 0; blk < 8; ++blk) { aC[blk] = mm(lds + blk * SBB, mt, Cm, nt, g, c, z4); aS[blk] = mm(lds + blk * SBB, mt, Sm, nt, g, c, z4); }
                      const int n_ = gI * 64 + 16 * nt + c;
                      if (it < 256) {
#pragma unroll
                          for (int r = 0; r < 4; ++r) { const int l1 = 16 * mt + 4 * g + r; bf16* dst = W_(bf16, WS_D1) + ((((size_t)(b * 512 + n_) * 64 + l1) * 2) * 128 + 8 * q);
                              v4u wr_, wi_;
                              wr_.x = pk2(aC[0][r], aC[1][r]); wr_.y = pk2(aC[2][r], aC[3][r]); wr_.z = pk2(aC[4][r], aC[5][r]); wr_.w = pk2(aC[6][r], aC[7][r]);
                              wi_.x = pk2(-aS[0][r], -aS[1][r]); wi_.y = pk2(-aS[2][r], -aS[3][r]); wi_.z = pk2(-aS[4][r], -aS[5][r]); wi_.w = pk2(-aS[6][r], -aS[7][r]);
                              *(v4u*)dst = wr_; *(v4u*)(dst + 128) = wi_; }
                      } else {
#pragma unroll
                          for (int blk = 0; blk < 4; ++blk) { bf16* dst = W_(bf16, WS_FTC) + ((size_t)b * 512 + n_) * 512 + 64 * blk + 16 * mt + 4 * g;
                              *(v2u*)dst = pack4(aC[blk]); *(v2u*)(dst + CTX) = pack4(aS[blk]); }
                      }
                  }
              }
              __syncthreads();
            }
        }
        ENDPH(pb + 2);
        if (IN(pb + 3)) { PH_BEGIN
            { pg8::Gemm g{W_(bf16, WS_LA), W_(bf16, WS_WL1), MR, 4096, 256, 512, 256}; pg8::StaticOrder S; S.init(MR, 4096, G, bx);
              pg8::EpiLora1 E{W_(unsigned short, WS_LW), W_(bf16, WS_AA), INP(9) + (size_t)l * 2048, INP(11) + (size_t)l * 2048, DSTR};
              pg8::gemm_phase<pg8::EpiLora1, pg8::StaticOrder, true, true>(lds + RING_OFF, g, S, E, tid); }
            asm volatile("" : "+v"(tid));
            { pg8::Gemm g{W_(bf16, WS_F1), W_(bf16, WS_D1), 256, 65536, 256, 256, 256}; pg8::StaticOrder S; S.init(256, 65536, G, bx);
              pg8::EpiFFT1 E{W_(bf16, WS_D2)};
              pg8::gemm_phase<pg8::EpiFFT1, pg8::StaticOrder, true, true>(lds + RING_OFF, g, S, E, tid); }
            for (int b = 0; b < 2; ++b) {
                asm volatile("" : "+v"(tid));
                pg8::Gemm g{W_(bf16, WS_DFTC), W_(bf16, WS_FTC) + (size_t)b * 512 * 512, CTX, 512, 512, 512, 512}; pg8::StaticOrder S; S.init(CTX, 512, G, (bx + G - 48 - b * 2) % G);
                pg8::EpiStoreBf16 E{W_(bf16, WS_MIX), DM, ML + b * CTX, 1536, 0.0078125f};
                pg8::gemm_phase<pg8::EpiStoreBf16, pg8::StaticOrder, true, true>(lds + RING_OFF, g, S, E, tid); }
        }
        ENDPH(pb + 3);
        if (IN(pb + 4)) { PH_BEGIN
            { const float* sh = INP(8) + (size_t)l * 3 * RWC;
              const int hq = gw & 3, c = hq * 256 + lane * 4, h = c >> 6;
              f32x4 shc[3][3];
#pragma unroll
              for (int q = 0; q < 3; ++q)
#pragma unroll
                  for (int w3 = 0; w3 < 3; ++w3) shc[q][w3] = *(const f32x4*)(sh + w3 * RWC + q * 1024 + c);
              const f32x4 kk4 = *(const f32x4*)(INP(13) + (size_t)l * 1024 + c), ka4 = *(const f32x4*)(INP(14) + (size_t)l * 1024 + c), rk4 = *(const f32x4*)(INP(15) + (size_t)l * 1024 + c);
              constexpr int RB = 2;
              for (int r0 = gw >> 2; r0 < MR; r0 += RB * (NGW >> 2)) {
                v2u wc_[RB][3], wp_[RB][3], wn_[RB][3], aw_[RB][2];
#pragma unroll
                for (int i = 0; i < RB; ++i) { const int rr = r0 + i * (NGW >> 2), r = rr < MR ? rr : MR - 1; int t, len; row_seg(r, t, len);
                    const bf16* p = W_(bf16, WS_PX) + (size_t)r * DINP;
#pragma unroll
                    for (int q = 0; q < 3; ++q) { const int sc = q * 1024 + c;
                        wc_[i][q] = *(const v2u*)(p + sc); wp_[i][q] = (v2u){0u, 0u}; wn_[i][q] = (v2u){0u, 0u};
                        if (t > 0) wp_[i][q] = *(const v2u*)(p - DINP + sc); if (t < len - 1) wn_[i][q] = *(const v2u*)(p + DINP + sc); }
#pragma unroll
                    for (int d = 0; d < 2; ++d) aw_[i][d] = *(const v2u*)(W_(bf16, WS_AA) + d * DSTR + (size_t)r * 1024 + c); }
#pragma unroll
                for (int i = 0; i < RB; ++i) { const int r = r0 + i * (NGW >> 2);
                  if (r < MR) {
                    f32x4 sv[3];
#pragma unroll
                    for (int q = 0; q < 3; ++q) { const v2u wc0 = wc_[i][q], wp = wp_[i][q], wn = wn_[i][q];
                        const f32x4 cu = {bflo(wc0.x), bfhi(wc0.x), bflo(wc0.y), bfhi(wc0.y)}, pr = {bflo(wp.x), bfhi(wp.x), bflo(wp.y), bfhi(wp.y)}, nx = {bflo(wn.x), bfhi(wn.x), bflo(wn.y), bfhi(wn.y)};
                        sv[q] = shc[q][0] * pr + shc[q][1] * cu + shc[q][2] * nx; }
                    const f32x4 rv = sv[0], kv = sv[1], vv = sv[2];
                    f32x4 kk = kv * kk4; float n2 = (kk[0] * kk[0] + kk[1] * kk[1]) + (kk[2] * kk[2] + kk[3] * kk[3]);
                    n2 = sum16(n2, lane); kk = kk * (1.0f / fmaxf(sqrtf(n2), KK_EPS));
                    f32x4 ksum = {0.f, 0.f, 0.f, 0.f};
#pragma unroll
                    for (int d = 0; d < 2; ++d) { const v2u aw = aw_[i][d]; const f32x4 a = {sigm(bflo(aw.x)), sigm(bfhi(aw.x)), sigm(bflo(aw.y)), sigm(bfhi(aw.y))};
                        const f32x4 kd = kv * (1.0f + (a - 1.0f) * ka4), bh = kk * a; ksum += kd;
                        *(v2u*)(W_(bf16, WS_KD) + d * DSTR + (size_t)r * 1024 + c) = (v2u){pk2(kd[0], kd[1]), pk2(kd[2], kd[3])};
                        *(v2u*)(W_(bf16, WS_BH) + d * DSTR + (size_t)r * 1024 + c) = (v2u){pk2(bh[0], bh[1]), pk2(bh[2], bh[3])}; }
                    const f32x4 bq = rv * ksum * rk4; float bo = (bq[0] + bq[1]) + (bq[2] + bq[3]);
                    bo = sum16(bo, lane);
                    if ((lane & 15) == 0) W_(float, WS_BONUS)[(size_t)r * 16 + h] = bo;
                    *(v2u*)(W_(bf16, WS_RS) + (size_t)r * 1024 + c) = (v2u){pk2(rv[0], rv[1]), pk2(rv[2], rv[3])};
                    *(v2u*)(W_(bf16, WS_VS) + (size_t)r * 1024 + c) = (v2u){pk2(vv[0], vv[1]), pk2(vv[2], vv[3])};
                    *(v2u*)(W_(bf16, WS_KK) + (size_t)r * 1024 + c) = (v2u){pk2(kk[0], kk[1]), pk2(kk[2], kk[3])};
                  } }
              } }
        }
        ENDPH(pb + 4);
        if (IN(pb + 5)) { PH_BEGIN
            const int g = lane >> 4, c = lane & 15, mt = wave & 3, nt0 = 2 * (wave >> 2);
            constexpr int SBB = 9216;
#define BUF(i) (lds + (i) * SBB)
#define LBAR() do { asm volatile("s_waitcnt lgkmcnt(0)" ::: "memory"); __builtin_amdgcn_s_barrier(); asm volatile("" ::: "memory"); } while (0)
            constexpr int B_AN = 0, B_BN = 1, B_KN = 2, B_RN = 3, B_VN = 4, B_SPN = 5, B_SPT = 6, B_TP = 7, B_S0N = 8, B_S0T = 9, B_T1 = 10, B_AAK = 11, B_ARB = 12, B_ARK = 13, B_M2T = 14;
            LAS float* gam = (LAS float*)(lds + 15 * SBB);
            const f32x4 z4 = {0.f, 0.f, 0.f, 0.f};
            v4u rs_, kd_, vs_, kk_, bh_, lwh_;
#define S1_ROWBASE(it_, rb_, d_, h_) do { const int inst_ = (it_) / NCH, s_ = (it_) - inst_ * NCH; const int b_ = inst_ >> 5; h_ = (inst_ >> 1) & 15; d_ = inst_ & 1; \
    if (s_ < 4) { const int cc = d_ ? 3 - s_ : s_; rb_ = ML + b_ * CTX + cc * 64; } else { const int cc = d_ ? 127 - (s_ - 4) : (s_ - 4); rb_ = b_ * SEQ + cc * 64; } } while (0)
#define S1_LOAD(it_) do { int rb_, d_, h_; S1_ROWBASE(it_, rb_, d_, h_); const int row = rb_ + (d_ ? 63 - lane : lane); const size_t off = (size_t)row * 1024 + h_ * 64 + wave * 8; \
    rs_ = *(const v4u*)(W_(bf16, WS_RS) + off); kd_ = *(const v4u*)(W_(bf16, WS_KD) + d_ * DSTR + off); vs_ = *(const v4u*)(W_(bf16, WS_VS) + off); \
    kk_ = *(const v4u*)(W_(bf16, WS_KK) + off); bh_ = *(const v4u*)(W_(bf16, WS_BH) + d_ * DSTR + off); \
    lwh_ = *(const v4u*)(W_(unsigned short, WS_LW) + d_ * DSTR + off); } while (0)
            const int per_ = (64 * NCH + G - 1) / G, it_end = (bx + 1) * per_ < 64 * NCH ? (bx + 1) * per_ : 64 * NCH;
            if (bx * per_ < it_end) S1_LOAD(bx * per_);
            for (int it = bx * per_; it < it_end; ++it) {
                { float lwv[8], lam[8]; pg8::unpack_h8(lwh_, lwv);
#pragma unroll
                  for (int e = 0; e < 8; ++e) lwv[e] = -0.6065306597126334f * sigm(lwv[e]);
#pragma unroll
                  for (int e = 0; e < 8; ++e) lam[e] = wave_incl_scan(lwv[e]);
                  if (lane == 63) {
#pragma unroll
                      for (int e = 0; e < 8; ++e) gam[wave * 8 + e] = __expf(lam[e]); }
                  float r_[8], k_[8], q_[8], b_[8], an[8], rn[8], bn[8], kn[8];
                  unpack8(rs_, r_); unpack8(kd_, k_); unpack8(kk_, q_); unpack8(bh_, b_);
#pragma unroll
                  for (int e = 0; e < 8; ++e) { const float eL = __expf(lam[e]), eLx = __expf(lam[e] - lwv[e]), emL = __expf(-lam[e]);
                      an[e] = -q_[e] * eLx; rn[e] = r_[e] * eL; bn[e] = b_[e] * emL; kn[e] = k_[e] * emL; }
                  *(LAS v4u*)(BUF(B_AN) + lane * 144 + wave * 16) = pack8(an); *(LAS v4u*)(BUF(B_RN) + lane * 144 + wave * 16) = pack8(rn);
                  *(LAS v4u*)(BUF(B_BN) + lane * 144 + wave * 16) = pack8(bn); *(LAS v4u*)(BUF(B_KN) + lane * 144 + wave * 16) = pack8(kn);
                  *(LAS v4u*)(BUF(B_VN) + lane * 144 + wave * 16) = vs_;
                }
                if (it + 1 < it_end) S1_LOAD(it + 1);
                LBAR();
                { const bool nzq[2] = {nt0 <= mt, nt0 + 1 <= mt};
                  const pg8::bf16x8 zf = {0, 0, 0, 0, 0, 0, 0, 0}; Fr2 fA, fR, fB[2], fK[2]; fA.k0 = zf; fA.k1 = zf; fR = fA; fB[0] = fA; fB[1] = fA; fK[0] = fA; fK[1] = fA;
                  if (nzq[0]) { fA = ldf2(BUF(B_AN), mt, g, c); fR = ldf2(BUF(B_RN), mt, g, c); }
#pragma unroll
                  for (int q = 0; q < 2; ++q) if (nzq[q]) { fB[q] = ldf2(BUF(B_BN), nt0 + q, g, c); fK[q] = ldf2(BUF(B_KN), nt0 + q, g, c); }
                  f32x4 abn[2], abt[2], akn[2], rbn[2], rkn[2];
#pragma unroll
                  for (int q = 0; q < 2; ++q) { abn[q] = z4; abt[q] = z4; akn[q] = z4; rbn[q] = z4; rkn[q] = z4;
                      if (nzq[q]) { abn[q] = mmf(fB[q], fA, z4); if (nt0 + q == mt) abt[q] = mmf(fA, fB[q], z4); akn[q] = mmf(fK[q], fA, z4); rbn[q] = mmf(fB[q], fR, z4); rkn[q] = mmf(fK[q], fR, z4); } }
#pragma unroll
                  for (int q = 0; q < 2; ++q) { const int nt = nt0 + q;
                    const int mN = 16 * mt + c, nN = 16 * nt + 4 * g;
                    const int mT = 16 * mt + 4 * g, nT = 16 * nt + c;
#pragma unroll
                    for (int r = 0; r < 4; ++r) { const bool st = (nN + r) < mN, inc = (nN + r) <= mN;
                        abn[q][r] = st ? abn[q][r] : 0.f; akn[q][r] = st ? akn[q][r] : 0.f; rbn[q][r] = inc ? rbn[q][r] : 0.f; rkn[q][r] = inc ? rkn[q][r] : 0.f;
                        abt[q][r] = nT < (mT + r) ? abt[q][r] : 0.f; }
                    st_nat(BUF(B_S0N), mt, nt, g, c, abn[q]); if (nt == mt) st_tr(BUF(B_S0T), mt, nt, g, c, abt[q]);
                    st_nat(BUF(B_AAK), mt, nt, g, c, akn[q]); st_nat(BUF(B_ARB), mt, nt, g, c, rbn[q]); st_nat(BUF(B_ARK), mt, nt, g, c, rkn[q]);
                    st_nat(BUF(B_SPN), mt, nt, g, c, z4); if (nt != mt) st_nat(BUF(B_TP), mt, nt, g, c, z4); } }
                LBAR();
                Fr2 fVt[2];
                { const Fr2 fAK = ldf2(BUF(B_AAK), mt, g, c); f32x4 m2[2];
#pragma unroll
                  for (int q = 0; q < 2; ++q) fVt[q] = ldf2_tr(BUF(B_VN), nt0 + q, g, c);
#pragma unroll
                  for (int q = 0; q < 2; ++q) m2[q] = mmf(fAK, fVt[q], z4);
#pragma unroll
                  for (int q = 0; q < 2; ++q) st_tr(BUF(B_M2T), mt, nt0 + q, g, c, m2[q]);
                  if (nt0 == 2 * (mt >> 1)) {
                      const int to = (16 * mt + c) * 144 + (16 * mt + 4 * g) * 2;
                      const v2u wN = *(LAS const v2u*)(BUF(B_S0N) + to), wT = *(LAS const v2u*)(BUF(B_S0T) + to);
#define S1_FR(w_) __builtin_bit_cast(pg8::bf16x8, ((pg8::u32x4){(w_).x, (w_).y, 0u, 0u}))
                      f32x4 tn = {bflo(wN.x), bfhi(wN.x), bflo(wN.y), bfhi(wN.y)};
#pragma unroll
                      for (int r = 0; r < 4; ++r) tn[r] += (4 * g + r) == c ? 1.f : 0.f;
                      const v2u wI = pack4(tn);
                      pg8::bf16x8 fSN = S1_FR(wN), fST = S1_FR(wT), fTN = S1_FR(wI);
#pragma unroll
                      for (int rr = 1; rr <= 4; ++rr) {
                          if (rr >= 2) tn = __builtin_amdgcn_mfma_f32_16x16x32_bf16(fST, fTN, tn, 0, 0, 0);
                          if (rr <= 3) { const f32x4 zn = __builtin_amdgcn_mfma_f32_16x16x32_bf16(fST, fSN, z4, 0, 0, 0), zt = __builtin_amdgcn_mfma_f32_16x16x32_bf16(fSN, fST, z4, 0, 0, 0);
                              const v2u pn = pack4(zn), pt = pack4(zt); fSN = S1_FR(pn); fST = S1_FR(pt); }
                          if (rr >= 2 && rr <= 3) { const v2u pq = pack4(tn); fTN = S1_FR(pq); }
                      }
#undef S1_FR
                      st_nat(BUF(B_TP), mt, mt, g, c, tn); } }
                LBAR();
                if (wave < 2) {
                    const int mb = wave ? 3 : 1, nb = wave ? 2 : 0, ks = wave;
                    const f32x4 u = __builtin_amdgcn_mfma_f32_16x16x32_bf16(ldf_tr(BUF(B_TP), nb, ks, g, c), ldf(BUF(B_S0N), mb, ks, g, c), z4, 0, 0, 0);
                    st_nat(BUF(B_SPN), mb, nb, g, c, u);
                    asm volatile("s_waitcnt lgkmcnt(0)" ::: "memory");
                    const f32x4 v = __builtin_amdgcn_mfma_f32_16x16x32_bf16(ldf_tr(BUF(B_SPN), nb, ks, g, c), ldf(BUF(B_TP), mb, ks, g, c), z4, 0, 0, 0);
                    st_nat(BUF(B_TP), mb, nb, g, c, v); }
                LBAR();
                if (wave < 4) {
                    const int mb = 2 + (wave >> 1), nb = wave & 1;
                    const f32x4 y = __builtin_amdgcn_mfma_f32_16x16x32_bf16(ldf_tr(BUF(B_TP), nb, 0, g, c), ldf(BUF(B_S0N), mb, 0, g, c), z4, 0, 0, 0);
                    st_nat(BUF(B_SPN), mb, nb, g, c, y); }
                LBAR();
                if (wave < 4) {
                    const int mb = 2 + (wave >> 1), nb = wave & 1;
                    const f32x4 x = __builtin_amdgcn_mfma_f32_16x16x32_bf16(ldf_tr(BUF(B_SPN), nb, 1, g, c), ldf(BUF(B_TP), mb, 1, g, c), z4, 0, 0, 0);
                    st_nat(BUF(B_TP), mb, nb, g, c, x); }
                LBAR();
                { const bool hi = mt >= 2;
                  const pg8::bf16x8 fT0 = ldf(BUF(B_TP), mt, 0, g, c); f32x4 w1[2], ul[2];
#pragma unroll
                  for (int q = 0; q < 2; ++q) { w1[q] = __builtin_amdgcn_mfma_f32_16x16x32_bf16(fT0, ldf_tr(BUF(B_AN), nt0 + q, 0, g, c), z4, 0, 0, 0); ul[q] = __builtin_amdgcn_mfma_f32_16x16x32_bf16(fT0, ldf(BUF(B_M2T), nt0 + q, 0, g, c), z4, 0, 0, 0); }
                  if (hi) { const pg8::bf16x8 fT1 = ldf(BUF(B_TP), mt, 1, g, c);
#pragma unroll
                      for (int q = 0; q < 2; ++q) { w1[q] = __builtin_amdgcn_mfma_f32_16x16x32_bf16(fT1, ldf_tr(BUF(B_AN), nt0 + q, 1, g, c), w1[q], 0, 0, 0); ul[q] = __builtin_amdgcn_mfma_f32_16x16x32_bf16(fT1, ldf(BUF(B_M2T), nt0 + q, 1, g, c), ul[q], 0, 0, 0); } }
#pragma unroll
                  for (int q = 0; q < 2; ++q) { st_tr(BUF(B_S0N), mt, nt0 + q, g, c, w1[q]); st_tr(BUF(B_T1), mt, nt0 + q, g, c, ul[q]); } }
                LBAR();
                { const int ix_ = (it % NCH) * 64 + it / NCH;
                  unsigned char* ib = ix_ < SCR1_ITEMS ? W_(unsigned char, WS_SCR1) + (size_t)ix_ * ITEM_BYTES : W_(unsigned char, WS_SCR3) + (size_t)(ix_ - SCR1_ITEMS) * ITEM_BYTES;
                  const bool hi = mt >= 2;
                  Fr2 fARB, fARK; fARB.k0 = ldf(BUF(B_ARB), mt, 0, g, c); fARK.k0 = ldf(BUF(B_ARK), mt, 0, g, c); fARB.k1 = fARB.k0; fARK.k1 = fARK.k0;
                  if (hi) { fARB.k1 = ldf(BUF(B_ARB), mt, 1, g, c); fARK.k1 = ldf(BUF(B_ARK), mt, 1, g, c); }
                  const Fr2 fBT = ldf2_tr(BUF(B_BN), mt, g, c), fKT = ldf2_tr(BUF(B_KN), mt, g, c);
                  const float gj = gam[16 * mt + c]; const f32x4 g4 = *(LAS const f32x4*)(gam + 16 * mt + 4 * g);
#pragma unroll
                  for (int q = 0; q < 2; ++q) { const int nt = nt0 + q; const int pcol = 32 * (nt >> 1) + 8 * g + 4 * (nt & 1);
                      const Fr2 fUL = ldf2(BUF(B_T1), nt, g, c), fW1 = ldf2(BUF(B_S0N), nt, g, c);
                      const v2u rw = *(LAS const v2u*)(BUF(B_RN) + (16 * mt + c) * 144 + (16 * nt + 4 * g) * 2); const f32x4 r0 = {bflo(rw.x), bfhi(rw.x), bflo(rw.y), bfhi(rw.y)};
                      f32x4 yl = __builtin_amdgcn_mfma_f32_16x16x32_bf16(fUL.k0, fARB.k0, z4, 0, 0, 0); yl = __builtin_amdgcn_mfma_f32_16x16x32_bf16(fVt[q].k0, fARK.k0, yl, 0, 0, 0);
                      f32x4 rh = __builtin_amdgcn_mfma_f32_16x16x32_bf16(fW1.k0, fARB.k0, r0, 0, 0, 0);
                      if (hi) { yl = __builtin_amdgcn_mfma_f32_16x16x32_bf16(fUL.k1, fARB.k1, yl, 0, 0, 0); yl = __builtin_amdgcn_mfma_f32_16x16x32_bf16(fVt[q].k1, fARK.k1, yl, 0, 0, 0); rh = __builtin_amdgcn_mfma_f32_16x16x32_bf16(fW1.k1, fARB.k1, rh, 0, 0, 0); }
                      f32x4 pt = mmf(fW1, fBT, z4);
                      f32x4 qq = mmf(fBT, fUL, z4); qq = mmf(fKT, fVt[q], qq);
                      *(LAS v2u*)(BUF(B_S0T) + (16 * nt + c) * 144 + (16 * g + 4 * mt) * 2) = pack4(yl);
                      *(LAS v2u*)(BUF(B_SPT) + (16 * mt + c) * 144 + pcol * 2) = pack4(rh);
#pragma unroll
                      for (int r = 0; r < 4; ++r) pt[r] = gj * (pt[r] + ((16 * nt + 4 * g + r) == (16 * mt + c) ? 1.f : 0.f));
                      *(LAS v2u*)(BUF(B_SPN) + (16 * mt + c) * 144 + pcol * 2) = pack4(pt);
                      *(LAS v2u*)(BUF(B_TP) + (16 * nt + c) * 144 + (16 * g + 4 * mt) * 2) = pack4(qq * g4); }
                  LBAR();
                  {
                    const int blk = tid >> 6, ln = tid & 63;
                    const int rowP = (blk >> 1) * 16 + (ln & 15), chP = (blk & 1) * 4 + (ln >> 4);
                    const int rowQ = (blk >> 1) * 16 + (ln & 15), offQ = (ln >> 4) * 32 + (blk & 1) * 16;
                    const v4u o0 = *(LAS const v4u*)(BUF(B_SPN) + rowP * 144 + chP * 16), o1 = *(LAS const v4u*)(BUF(B_SPT) + rowP * 144 + chP * 16);
                    const v4u o2 = *(LAS const v4u*)(BUF(B_TP) + rowQ * 144 + offQ), o3 = *(LAS const v4u*)(BUF(B_S0T) + rowQ * 144 + offQ);
                    unsigned char* op = ib + tid * 16;
                    *(v4u*)op = o0; *(v4u*)(op + 8192) = o1; *(v4u*)(op + 16384) = o2; *(v4u*)(op + 24576) = o3; } }
                LBAR();
            }
#undef BUF
#undef LBAR
#undef S1_LOAD
#undef S1_ROWBASE
        }
        if (IN(pb + 5) && IN(pb + 6)) { if (G0 == 64 * NSEG) { asm volatile("s_waitcnt vmcnt(0)" ::: "memory"); __syncthreads(); } else GRID_BAR(); }
        if (IN(pb + 6)) { PH_BEGIN
            const int g = lane >> 4, c = lane & 15;
#define S2_ITEM(s_, inst_) (((s_) * 64 + (inst_)) < SCR1_ITEMS ? W_(unsigned char, WS_SCR1) + (size_t)((s_) * 64 + (inst_)) * ITEM_BYTES : W_(unsigned char, WS_SCR3) + (size_t)((s_) * 64 + (inst_) - SCR1_ITEMS) * ITEM_BYTES)
#define S2_COMPOSITE(inst_, j_) (W_(unsigned char, WS_COMP) + (size_t)((inst_) * (NSEG - 1) + (j_)) * ITEM_BYTES)
#define S2_UNP(w_) (f32x4){bflo((w_).x), bfhi((w_).x), bflo((w_).y), bfhi((w_).y)}
#define S2_UNP2(w_) (f32x4){bflo((w_).z), bfhi((w_).z), bflo((w_).w), bfhi((w_).w)}
#define S2_PACKH(a_, b_) ({ pg8::u32x4 w_; w_.x = pg8::cvt_pk_bf16((a_)[0], (a_)[1]); w_.y = pg8::cvt_pk_bf16((a_)[2], (a_)[3]); w_.z = pg8::cvt_pk_bf16((b_)[0], (b_)[1]); w_.w = pg8::cvt_pk_bf16((b_)[2], (b_)[3]); __builtin_bit_cast(pg8::bf16x8, w_); })
            for (int u = bx; u < 64 * NSEG; u += G) {
                const int inst = G == 64 * NSEG ? u >> 2 : u & 63, seg = G == 64 * NSEG ? u & 3 : u >> 6;
                if (seg == NSEG - 1) continue;
                const int lw = wave & 3;
                unsigned goff[4];
#pragma unroll
                for (int j = 0; j < 4; ++j) goff[j] = (unsigned)((j < 2 ? 2 * lw + j : 14 + 2 * lw + j) * 1024 + lane * 16);
#define S2A_ISSUE(slot, t_) do { if (wave >= 4) { const unsigned char* ib = S2_ITEM(seg * SEGLEN + (t_), inst); \
    _Pragma("unroll") for (int j = 0; j < 4; ++j) __builtin_amdgcn_global_load_lds((const unsigned*)(ib + goff[j]), (LAS unsigned*)(lds + (slot) * 32768 + (j < 2 ? 2 * lw + j : 14 + 2 * lw + j) * 1024), 16, 0, 0); } } while (0)
#define S2A_WAIT(t_) do { if (wave >= 4) { if ((t_) >= SEGLEN - 3) asm volatile("s_waitcnt vmcnt(0)" ::: "memory"); else asm volatile("s_waitcnt vmcnt(8)" ::: "memory"); } \
    __builtin_amdgcn_s_barrier(); asm volatile("" ::: "memory"); } while (0)
                pg8::bf16x8 Hq0 = {0, 0, 0, 0, 0, 0, 0, 0}, Hq1 = Hq0, Hp0, Hp1;
                { unsigned p0[4] = {0u, 0u, 0u, 0u}, p1[4] = {0u, 0u, 0u, 0u}; const int jt = 16 * wave + c;
#pragma unroll
                  for (int e = 0; e < 8; ++e) { const int j = 16 * (e >> 2) + 4 * g + (e & 3); const unsigned one = 0x3F80u << (16 * (e & 1));
                      if (j == jt) p0[e >> 1] |= one; if (j + 32 == jt) p1[e >> 1] |= one; }
                  Hp0 = __builtin_bit_cast(pg8::bf16x8, ((pg8::u32x4){p0[0], p0[1], p0[2], p0[3]})); Hp1 = __builtin_bit_cast(pg8::bf16x8, ((pg8::u32x4){p1[0], p1[1], p1[2], p1[3]})); }
                __syncthreads();
                S2A_ISSUE(0, 0); S2A_ISSUE(1, 1); S2A_ISSUE(2, 2);
                for (int t = 0; t < SEGLEN; ++t) {
                    S2A_WAIT(t);
                    if (t + 3 < SEGLEN) S2A_ISSUE((t + 3) & 3, t + 3);
                    if (wave < 4) {
                        LAS const unsigned char* sl_ = lds + (t & 3) * 32768 + lane * 16;
                        const v4u q0 = *(LAS const v4u*)(sl_ + (16 + 2 * wave) * 1024), q1 = *(LAS const v4u*)(sl_ + (17 + 2 * wave) * 1024);
                        pg8::bf16x8 pf_[4][2];
#pragma unroll
                        for (int k = 0; k < 8; ++k) pf_[k >> 1][k & 1] = *(LAS const pg8::bf16x8*)(sl_ + k * 1024);
                        const f32x4 z4 = {0.f, 0.f, 0.f, 0.f};
                        f32x4 aq[4] = {S2_UNP(q0), S2_UNP2(q0), S2_UNP(q1), S2_UNP2(q1)}, ap[4] = {z4, z4, z4, z4};
#pragma unroll
                        for (int jb = 0; jb < 4; ++jb) {
                            aq[jb] = __builtin_amdgcn_mfma_f32_16x16x32_bf16(pf_[jb][0], Hq0, aq[jb], 0, 0, 0); ap[jb] = __builtin_amdgcn_mfma_f32_16x16x32_bf16(pf_[jb][0], Hp0, ap[jb], 0, 0, 0);
                            aq[jb] = __builtin_amdgcn_mfma_f32_16x16x32_bf16(pf_[jb][1], Hq1, aq[jb], 0, 0, 0); ap[jb] = __builtin_amdgcn_mfma_f32_16x16x32_bf16(pf_[jb][1], Hp1, ap[jb], 0, 0, 0); }
                        Hq0 = S2_PACKH(aq[0], aq[1]); Hq1 = S2_PACKH(aq[2], aq[3]); Hp0 = S2_PACKH(ap[0], ap[1]); Hp1 = S2_PACKH(ap[2], ap[3]);
                    }
                }
                asm volatile("s_waitcnt vmcnt(0)" ::: "memory");
                __syncthreads();
                unsigned char* cb = S2_COMPOSITE(inst, seg);
                if (wave < 4) {
                    *(v4u*)(cb + (16 + 2 * wave) * 1024 + lane * 16) = __builtin_bit_cast(v4u, Hq0); *(v4u*)(cb + (17 + 2 * wave) * 1024 + lane * 16) = __builtin_bit_cast(v4u, Hq1);
                    const v4u w0 = __builtin_bit_cast(v4u, Hp0), w1 = __builtin_bit_cast(v4u, Hp1);
                    const unsigned ww[8] = {w0.x, w0.y, w0.z, w0.w, w1.x, w1.y, w1.z, w1.w};
#pragma unroll
                    for (int jb = 0; jb < 4; ++jb)
#pragma unroll
                        for (int r = 0; r < 4; ++r) { const unsigned wd_ = ww[jb * 2 + (r >> 1)]; const unsigned short hv = (unsigned short)((r & 1) ? (wd_ >> 16) : (wd_ & 0xffffu));
                            *(LAS unsigned short*)(lds + (16 * jb + 4 * g + r) * 144 + (16 * wave + c) * 2) = hv; }
                }
                __syncthreads();
                { const int rowblk = wave >> 1, ks = wave & 1;
                  LAS const unsigned char* rp = lds + (16 * rowblk + c) * 144 + (32 * ks + 4 * g) * 2;
                  const v2u lo_ = *(LAS const v2u*)rp, hi_ = *(LAS const v2u*)(rp + 32);
                  *(v4u*)(cb + wave * 1024 + lane * 16) = (v4u){lo_.x, lo_.y, hi_.x, hi_.y}; }
                asm volatile("s_waitcnt vmcnt(0)" ::: "memory");
                __syncthreads();
                if (tid == 0) { __builtin_amdgcn_fence(__ATOMIC_RELEASE, "agent"); (void)xb_add(W_(unsigned, WS_CTL + SCAN_FLAG_OFF) + l * 256 + u, 1u); }
#undef S2A_ISSUE
#undef S2A_WAIT
            }
            __syncthreads();
            { pg8::Gemm g{W_(bf16, WS_D2), W_(bf16, WS_F2), 131072, 256, 128, 128, 128}; pg8::StaticOrder S; S.init(131072, 256, G, bx);
              pg8::EpiFFT2 E{W_(bf16, WS_MIX), 0.001381067932004975f};
              pg8::gemm_phase<pg8::EpiFFT2, pg8::StaticOrder, true, true>(lds + RING_OFF, g, S, E, tid); }
            asm volatile("" : "+v"(tid));
            { pg8::Gemm g{W_(bf16, WS_LA) + 256, W_(bf16, WS_WG), MR, 1024, 256, 512, 256}; pg8::StaticOrder S; S.init(MR, 1024, G, bx);
              pg8::EpiStoreBf16 E{W_(bf16, WS_G), 1024, 0, 0, 1.0f};
              pg8::gemm_phase<pg8::EpiStoreBf16, pg8::StaticOrder, true, true>(lds + RING_OFF, g, S, E, tid); }
            asm volatile("" : "+v"(tid));
            { const float* cw = INP(19) + (size_t)l * 3 * DC; const int c8 = (gt & 63) * 8; float w0[8], w1[8], w2[8];
#pragma unroll
              for (int j = 0; j < 8; ++j) { w0[j] = cw[c8 + j]; w1[j] = cw[DC + c8 + j]; w2[j] = cw[2 * DC + c8 + j]; }
              constexpr int RB = 2;
              for (int r0 = gt >> 6; r0 < MR; r0 += RB * (NGT >> 6)) {
                  v4u wg_[RB][3], wx_[RB][3], wb_[RB];
#pragma unroll
                  for (int i = 0; i < RB; ++i) { const int rr = r0 + i * (NGT >> 6), r = rr < MR ? rr : MR - 1; int t, len; row_seg(r, t, len);
                      const bool vp = r < ML ? (t & 63) > 0 : t > 0, vn = r < ML ? (t & 63) < 63 : t < len - 1;
                      const bf16* p = W_(bf16, WS_PX) + (size_t)r * DINP; const v4u z_ = {0u, 0u, 0u, 0u};
                      wg_[i][1] = *(const v4u*)(p + CG0 + c8); wx_[i][1] = *(const v4u*)(p + CX0 + c8); wb_[i] = *(const v4u*)(p + CB0 + c8);
                      wg_[i][0] = z_; wx_[i][0] = z_; wg_[i][2] = z_; wx_[i][2] = z_;
                      if (vp) { wg_[i][0] = *(const v4u*)(p - DINP + CG0 + c8); wx_[i][0] = *(const v4u*)(p - DINP + CX0 + c8); }
                      if (vn) { wg_[i][2] = *(const v4u*)(p + DINP + CG0 + c8); wx_[i][2] = *(const v4u*)(p + DINP + CX0 + c8); } }
#pragma unroll
                  for (int i = 0; i < RB; ++i) { const int r = r0 + i * (NGT >> 6);
                      if (r < MR) { float g0[8], x0[8], b0[8], gp[8], xp[8], gn[8], xn[8], o[8];
                          unpack8(wg_[i][1], g0); unpack8(wx_[i][1], x0); unpack8(wb_[i], b0); unpack8(wg_[i][0], gp); unpack8(wx_[i][0], xp); unpack8(wg_[i][2], gn); unpack8(wx_[i][2], xn);
#pragma unroll
                          for (int j = 0; j < 8; ++j) o[j] = b0[j] * (w0[j] * (gp[j] * xp[j]) + w1[j] * (g0[j] * x0[j]) + w2[j] * (gn[j] * xn[j]));
                          *(v4u*)(W_(bf16, WS_MIX) + (size_t)r * DM + 1024 + c8) = pack8(o); } } } }
        }
        if (IN(pb + 6) && IN(pb + 7)) { if (G0 == 64 * NSEG) { asm volatile("s_waitcnt vmcnt(0)" ::: "memory"); __syncthreads();
                if (tid0 == 0) { unsigned* fl = (unsigned*)(ws + WS_CTL + SCAN_FLAG_OFF) + l * 256 + (bx0 & ~3); unsigned* bar_ = (unsigned*)(ws + WS_CTL) + CW_BAR;
                    for (int j = 0; j < (bx0 & 3); ++j) XB_SPIN(xb_ld(&fl[j]) == 0u, bar_);
                    __builtin_amdgcn_fence(__ATOMIC_ACQUIRE, "agent"); }
                __syncthreads(); } else GRID_BAR(); }
        if (IN(pb + 7)) { PH_BEGIN
            const int g = lane >> 4, c = lane & 15;
            for (int u = bx; u < 64 * NSEG; u += G) {
                const int inst = G == 64 * NSEG ? u >> 2 : u & 63, seg = G == 64 * NSEG ? u & 3 : u >> 6, T = SEGLEN + seg;
                const int b = inst >> 5, h = (inst >> 1) & 15, d = inst & 1;
                bf16* Y = (d ? W_(bf16, WS_YB) : W_(bf16, WS_YF)) + h * 64 + 16 * (wave & 3) + 4 * g;
                pg8::bf16x8 Hf0 = {0, 0, 0, 0, 0, 0, 0, 0}, Hf1 = Hf0;
                unsigned goff[8];
#pragma unroll
                for (int j = 0; j < 8; ++j) goff[j] = (unsigned)((8 * (wave & 3) + j) * 1024 + lane * 16);
#define S2_ISSUE(slot, t_) do { if (wave >= 4) { const unsigned char* ib = (t_) < seg ? S2_COMPOSITE(inst, (t_)) : S2_ITEM(seg * SEGLEN + (t_) - seg, inst); \
    _Pragma("unroll") for (int j = 0; j < 8; ++j) __builtin_amdgcn_global_load_lds((const unsigned*)(ib + goff[j]), (LAS unsigned*)(lds + (slot) * 32768 + (8 * (wave & 3) + j) * 1024), 16, 0, 2);        } } while (0)
#define S2_WAIT(t_) do { if (wave >= 4) { if ((t_) >= T - 3) asm volatile("s_waitcnt vmcnt(0)" ::: "memory"); else asm volatile("s_waitcnt vmcnt(16)" ::: "memory"); } \
    __builtin_amdgcn_s_barrier(); asm volatile("" ::: "memory"); } while (0)
                __syncthreads();
                S2_ISSUE(0, 0); S2_ISSUE(1, 1); S2_ISSUE(2, 2);
                for (int t = 0; t < T; ++t) {
                    S2_WAIT(t);
                    if (t + 3 < T) S2_ISSUE((t + 3) & 3, t + 3);
                    if (wave < 4) {
                        LAS const unsigned char* sl_ = lds + (t & 3) * 32768 + lane * 16;
                        const v4u q0 = *(LAS const v4u*)(sl_ + (16 + 2 * wave) * 1024), q1 = *(LAS const v4u*)(sl_ + (17 + 2 * wave) * 1024);
                        pg8::bf16x8 pf_[4][2];
#pragma unroll
                        for (int k = 0; k < 8; ++k) pf_[k >> 1][k & 1] = *(LAS const pg8::bf16x8*)(sl_ + k * 1024);
                        f32x4 ah_[4] = {S2_UNP(q0), S2_UNP2(q0), S2_UNP(q1), S2_UNP2(q1)};
                        if (t >= seg) {
                            const int s = seg * SEGLEN + t - seg; int rowbase;
                            if (s < 4) { const int cc = d ? 3 - s : s; rowbase = ML + b * CTX + cc * 64; } else { const int cc = d ? 127 - (s - 4) : (s - 4); rowbase = b * SEQ + cc * 64; }
                            const v4u y0 = *(LAS const v4u*)(sl_ + (24 + 2 * wave) * 1024), y1 = *(LAS const v4u*)(sl_ + (25 + 2 * wave) * 1024);
                            pg8::bf16x8 rf_[4][2];
#pragma unroll
                            for (int k = 0; k < 8; ++k) rf_[k >> 1][k & 1] = *(LAS const pg8::bf16x8*)(sl_ + (8 + k) * 1024);
                            f32x4 ay_[4] = {S2_UNP(y0), S2_UNP2(y0), S2_UNP(y1), S2_UNP2(y1)};
#pragma unroll
                            for (int tb = 0; tb < 4; ++tb) { ay_[tb] = __builtin_amdgcn_mfma_f32_16x16x32_bf16(Hf0, rf_[tb][0], ay_[tb], 0, 0, 0); ay_[tb] = __builtin_amdgcn_mfma_f32_16x16x32_bf16(Hf1, rf_[tb][1], ay_[tb], 0, 0, 0);
                                const int tau = 16 * tb + c; *(v2u*)(Y + (size_t)(rowbase + (d ? 63 - tau : tau)) * 1024) = pack4(ay_[tb]); }
                        }
#pragma unroll
                        for (int jb = 0; jb < 4; ++jb) { ah_[jb] = __builtin_amdgcn_mfma_f32_16x16x32_bf16(pf_[jb][0], Hf0, ah_[jb], 0, 0, 0); ah_[jb] = __builtin_amdgcn_mfma_f32_16x16x32_bf16(pf_[jb][1], Hf1, ah_[jb], 0, 0, 0); }
                        Hf0 = S2_PACKH(ah_[0], ah_[1]); Hf1 = S2_PACKH(ah_[2], ah_[3]);
                    }
                }
                asm volatile("s_waitcnt vmcnt(0)" ::: "memory");
                __syncthreads();
#undef S2_ISSUE
#undef S2_WAIT
            }
#undef S2_ITEM
#undef S2_COMPOSITE
#undef S2_UNP
#undef S2_UNP2
#undef S2_PACKH
        }
        ENDPH(pb + 7);
        if (IN(pb + 8)) { PH_BEGIN
            { const int hq = gw & 3, c = hq * 256 + lane * 4, h = c >> 6;
              const f32x4 lnw4 = *(const f32x4*)(INP(16) + (size_t)l * 1024 + c), lnb4 = *(const f32x4*)(INP(17) + (size_t)l * 1024 + c);
              constexpr int RB = 4;
              for (int r0 = gw >> 2; r0 < MR; r0 += RB * (NGW >> 2)) {
                v2u yfw[RB], ybw[RB], vw[RB], gw_[RB]; float bo[RB];
#pragma unroll
                for (int i = 0; i < RB; ++i) { const int rr = r0 + i * (NGW >> 2), r = rr < MR ? rr : MR - 1;
                    yfw[i] = *(const v2u*)(W_(bf16, WS_YF) + (size_t)r * 1024 + c); ybw[i] = *(const v2u*)(W_(bf16, WS_YB) + (size_t)r * 1024 + c);
                    bo[i] = W_(float, WS_BONUS)[(size_t)r * 16 + h];
                    vw[i] = *(const v2u*)(W_(bf16, WS_VS) + (size_t)r * 1024 + c); gw_[i] = *(const v2u*)(W_(bf16, WS_G) + (size_t)r * 1024 + c); }
#pragma unroll
                for (int i = 0; i < RB; ++i) { const int r = r0 + i * (NGW >> 2);
                    const f32x4 yf = {bflo(yfw[i].x), bfhi(yfw[i].x), bflo(yfw[i].y), bfhi(yfw[i].y)}, yb = {bflo(ybw[i].x), bfhi(ybw[i].x), bflo(ybw[i].y), bfhi(ybw[i].y)};
                    const f32x4 y = yf + yb;
                    const float mu = sum16((y.x + y.y) + (y.z + y.w), lane) * (1.0f / 64.0f);
                    const f32x4 dv = y - mu;
                    const float var = sum16((dv.x * dv.x + dv.y * dv.y) + (dv.z * dv.z + dv.w * dv.w), lane) * (1.0f / 64.0f);
                    const float rstd = 1.0f / sqrtf(var + GN_EPS);
                    const f32x4 vv = {bflo(vw[i].x), bfhi(vw[i].x), bflo(vw[i].y), bfhi(vw[i].y)}, gv = {bflo(gw_[i].x), bfhi(gw_[i].x), bflo(gw_[i].y), bfhi(gw_[i].y)};
                    const f32x4 o = (dv * rstd * lnw4 + lnb4 + vv * bo[i]) * gv;
                    if (r < MR) *(v2u*)(W_(bf16, WS_MIX) + (size_t)r * DM + c) = (v2u){pk2(o[0], o[1]), pk2(o[2], o[3])}; }
              } }
        }
        ENDPH(pb + 8);
        if (IN(pb + 9)) { PH_BEGIN
            pg8::Gemm g{W_(bf16, WS_MIX), W_(bf16, WS_WOUT + (size_t)(l & 1) * WS_WSET), MR, DM, DM, DM, DM}; pg8::SplitOrder S; S.init(ML, l + 1 < DEPTH ? 2 : 0, DM, DM / 64, 4, G, bx);
            pg8::EpiResGate E{W_(unsigned short, WS_X), MODL + 2 * DM, W_(float, WS_PARTH), l == 0 ? INP(0) : (const float*)nullptr};
            pg8::gemm_phase<pg8::EpiResGate, pg8::SplitOrder, true, true>(lds + RING_OFF, g, S, E, tid);
        }
        ENDPH(pb + 9);
        if (IN(pb + 10)) { PH_BEGIN
            NORM_ROWS(INP(21) + (size_t)l * DM, 3 * DM, 4 * DM, (const float*)nullptr,
                      if (r >= ML) ctx_row_add_partials(W_(unsigned short, WS_X) + (size_t)r * DM, l == 0 ? INP(2) + (size_t)(r - ML) * DM : (const float*)nullptr, W_(float, WS_PARTH) + (size_t)(r - ML) * DM, MODL + 2 * MODW + 2 * DM, lane));
        }
        ENDPH(pb + 10);
        if (IN(pb + 11)) { PH_BEGIN
            const int mj = l + 1 < DEPTH ? MR : ML;
            pg8::Gemm g{W_(bf16, WS_XN), W_(bf16, WS_WGU + (size_t)(l & 1) * WS_WSET), mj, 2 * DFF, DM, DM, DM}; pg8::StaticOrder S; S.init(mj, 2 * DFF, G, bx);
            pg8::EpiSwiGLU E{W_(bf16, WS_H), DFF};
            pg8::gemm_phase<pg8::EpiSwiGLU, pg8::StaticOrder, true, true>(lds + RING_OFF, g, S, E, tid);
            TAIL_CONVERT(S.nwg, CVT_Q1, CVT_Q2, false);
        }
        ENDPH(pb + 11);
        if (IN(pb + 12)) { PH_BEGIN
            pg8::Gemm g{W_(bf16, WS_H), W_(bf16, WS_WDN + (size_t)(l & 1) * WS_WSET), MR, DM, DFF, DFF, DFF}; pg8::SplitOrder S; S.init(ML, l + 1 < DEPTH ? 2 : 0, DM, DFF / 64, 4, G, bx);
            pg8::EpiResGate E{W_(unsigned short, WS_X), MODL + 5 * DM, W_(float, WS_PARTK), (const float*)nullptr};
            pg8::gemm_phase<pg8::EpiResGate, pg8::SplitOrder, true, true>(lds + RING_OFF, g, S, E, tid);
            TAIL_CONVERT(S.nlat + S.nsub, CVT_Q2, CVT_NIT, false);
        }
        ENDPH(pb + 12);
    }
    if (IN(NPHASES - 1)) { PH_BEGIN
        for (int r = gw; r < ML; r += NGW) {
            const unsigned short* xr = W_(unsigned short, WS_X) + (size_t)r * DM; float v[4][8]; float s = 0.f;
#pragma unroll
            for (int jj = 0; jj < 4; ++jj) { pg8::unpack_h8(*(const v4u*)(xr + 8 * (64 * jj + lane)), v[jj]);
#pragma unroll
                for (int e = 0; e < 8; ++e) s += v[jj][e] * v[jj][e]; }
            const float rstd = 1.0f / sqrtf(wave_sum(s, lane) * (1.0f / DM) + RMS_EPS);
            float* o = (float*)(GAS float*)(args.out + (size_t)r * DM);
#pragma unroll
            for (int jj = 0; jj < 4; ++jj) { const int c8 = 8 * (64 * jj + lane); const f32x4 n0 = *(const f32x4*)(INP(25) + c8), n1 = *(const f32x4*)(INP(25) + c8 + 4);
                *(f32x4*)(o + c8) = (f32x4){v[jj][0], v[jj][1], v[jj][2], v[jj][3]} * rstd * n0; *(f32x4*)(o + c8 + 4) = (f32x4){v[jj][4], v[jj][5], v[jj][6], v[jj][7]} * rstd * n1; }
        }
    }
#undef IN
#undef ENDPH
}

extern "C" void kernel_launch(void* const* d_in, const int* in_sizes, int n_in, void* d_out, int out_size, void* d_ws, size_t ws_size, hipStream_t stream) {
    static int grid = 0;
    if (grid == 0) {
        if (n_in != 26 || ws_size < WS_END) { fprintf(stderr, "kernel_launch: bad inputs n_in %d ws %zu (need %zu)\n", n_in, ws_size, (size_t)WS_END); grid = -1; return; }
        int dev = 0, cus = 0, per_cu = 0;
        if (hipGetDevice(&dev) != hipSuccess || hipDeviceGetAttribute(&cus, hipDeviceAttributeMultiprocessorCount, dev) != hipSuccess) { grid = -1; return; }
        if (hipFuncSetAttribute((const void*)skel_fwd, hipFuncAttributeMaxDynamicSharedMemorySize, LDS_BYTES) != hipSuccess) { fprintf(stderr, "kernel_launch: hipFuncSetAttribute failed\n"); grid = -1; return; }
        if (hipOccupancyMaxActiveBlocksPerMultiprocessor(&per_cu, (const void*)skel_fwd, NWAVES * 64, LDS_BYTES) != hipSuccess || per_cu < 1)
            fprintf(stderr, "kernel_launch: occupancy query reports %d\n", per_cu);
        (void)hipGetLastError();
        grid = cus;
    }
    if (grid < 0) return;
    if (hipMemsetAsync((char*)d_ws + WS_CTL, 0, CTL_ZERO_BYTES, stream) != hipSuccess) return;
    Args a{};
    for (int i = 0; i < 26; ++i) a.in[i] = (const float*)d_in[i];
    a.out = (float*)d_out; a.ws = (unsigned char*)d_ws;
#if MK_ONE_LAUNCH
    a.ph_lo = 0; a.ph_hi = NPHASES;
    hipLaunchKernelGGL(skel_fwd, dim3(grid), dim3(NWAVES * 64), LDS_BYTES, stream, a);
#else
    for (int p = 0; p < NPHASES; ++p) { a.ph_lo = p; a.ph_hi = p + 1; hipLaunchKernelGGL(skel_fwd, dim3(grid), dim3(NWAVES * 64), LDS_BYTES, stream, a); }
#endif
}
```
